# Optimizing an MI355X kernel written in HIP

```python
import jax, jax.numpy as jnp
from jax import lax
import numpy as np

D_MODEL = 1024
BATCH = 32
SEQ = 256
DEPTH = 2
DEC_BATCH = 4
DEC_SEQ = 2048
PAST_LEN = 512

GRID_W = 64
N_EVEN = (DEPTH + 1) // 2
N_ODD = DEPTH // 2
MLA_HEADS = 8
Q_LORA = 384
KV_LORA = 256
QK_NOPE = 64
QK_ROPE = 32
V_HEAD = 64
CONV_CH = 512
CONV_W = 31
CONV_PAD = CONV_W // 2
GQA_HEADS = 16
GQA_KV_HEADS = 4
GQA_HEAD_DIM = 64
D_FF = 2816
MACARON = 0.5
N_MOD = 9
Q_BLOCK = 128
ROPE_BASE = 10000.0
EPS = 1e-6
IN_A = Q_LORA + KV_LORA + QK_ROPE + 2 * CONV_CH
MIX_A = MLA_HEADS * V_HEAD + CONV_CH
IN_C = (GQA_HEADS + 2 * GQA_KV_HEADS) * GQA_HEAD_DIM
MIX_C = GQA_HEADS * GQA_HEAD_DIM

kernel_name = 'hybrid_mla_conformer_gqa_diffusion_step'


def rms_norm(x, g):
    xf = x.astype(jnp.float32)
    y = xf * lax.rsqrt(jnp.mean(xf * xf, axis=-1, keepdims=True) + EPS)
    return y.astype(x.dtype) * g


def layer_norm(x, g, b):
    xf = x.astype(jnp.float32)
    mu = jnp.mean(xf, axis=-1, keepdims=True)
    var = jnp.mean(jnp.square(xf - mu), axis=-1, keepdims=True)
    return ((xf - mu) * lax.rsqrt(var + EPS)).astype(x.dtype) * g + b


def swiglu(h, w_in, w_out):
    a, b = jnp.split(h @ w_in, 2, axis=-1)
    return (jax.nn.silu(a) * b) @ w_out


def axial_rope(x):
    n, d = x.shape[1], x.shape[-1]
    half = d // 2
    rows = n // GRID_W
    pos_row = jnp.repeat(jnp.arange(rows), GRID_W)
    pos_col = jnp.tile(jnp.arange(GRID_W), rows)
    inv = ROPE_BASE ** (-jnp.arange(0, half, 2, dtype=jnp.float32) / half)

    def rot(xa, pos):
        ang = pos.astype(jnp.float32)[:, None] * inv[None, :]
        cos = jnp.cos(ang)[None, :, None, :].astype(x.dtype)
        sin = jnp.sin(ang)[None, :, None, :].astype(x.dtype)
        x1, x2 = jnp.split(xa, 2, axis=-1)
        return jnp.concatenate([x1 * cos - x2 * sin, x2 * cos + x1 * sin], axis=-1)

    return jnp.concatenate([rot(x[..., :half], pos_row), rot(x[..., half:], pos_col)], axis=-1)


def block_attention(q, k, v, scale):
    B, Sq, Hk, G, dk = q.shape
    nb = Sq // Q_BLOCK
    qb = q.reshape(B, nb, Q_BLOCK, Hk, G, dk).transpose(1, 0, 2, 3, 4, 5)

    def one(qblk):
        s = jnp.einsum('bqhgd,bshd->bhgqs', qblk, k).astype(jnp.float32) * scale
        p = jax.nn.softmax(s, axis=-1).astype(v.dtype)
        return jnp.einsum('bhgqs,bshd->bqhgd', p, v)

    o = lax.map(one, qb)
    return o.transpose(1, 0, 2, 3, 4, 5).reshape(B, Sq, Hk * G, v.shape[-1])


def depthwise_conv(u, w, b):
    y = lax.conv_general_dilated(u, w[:, None, :], window_strides=(1,), padding=[(CONV_PAD, CONV_PAD)],
                                 dimension_numbers=('NWC', 'WIO', 'NWC'), feature_group_count=u.shape[-1])
    return y + b


def mla_keys_values(ckv, kr, w_kv_up):
    B, S, _ = ckv.shape
    kv = (ckv @ w_kv_up).reshape(B, S, MLA_HEADS, QK_NOPE + V_HEAD)
    k_nope, v = kv[..., :QK_NOPE], kv[..., QK_NOPE:]
    k = jnp.concatenate([k_nope, jnp.broadcast_to(kr[:, :, None, :], (B, S, MLA_HEADS, QK_ROPE))], axis=-1)
    return k, v


def mla_conv_mixer(h, w_in, g_ql, w_qu, g_kvl, w_kvu, w_dw, b_dw, g_ln, b_ln, w_out, ctx):
    B, S, _ = h.shape
    cq, ckv, kr, u = jnp.split(h @ w_in, [Q_LORA, Q_LORA + KV_LORA, Q_LORA + KV_LORA + QK_ROPE], axis=-1)
    q = (rms_norm(cq, g_ql) @ w_qu).reshape(B, S, MLA_HEADS, QK_NOPE + QK_ROPE)
    ckv = rms_norm(ckv, g_kvl)
    if ctx is None:
        k, v = mla_keys_values(ckv, kr, w_kvu)
    else:
        q = jnp.concatenate([q[..., :QK_NOPE], axial_rope(q[..., QK_NOPE:])], axis=-1)
        kr_lat = axial_rope(kr[:, :, None, :])[:, :, 0, :]
        k_lat, v_lat = mla_keys_values(ckv, kr_lat, w_kvu)
        k_ctx, v_ctx = mla_keys_values(ctx[0], ctx[1], w_kvu)
        k = jnp.concatenate([k_ctx, k_lat], axis=1)
        v = jnp.concatenate([v_ctx, v_lat], axis=1)
    o = block_attention(q[:, :, :, None, :], k, v, (QK_NOPE + QK_ROPE) ** -0.5)
    attn = o.reshape(B, S, MLA_HEADS * V_HEAD)
    a, b = jnp.split(u, 2, axis=-1)
    g = depthwise_conv(a * jax.nn.sigmoid(b), w_dw, b_dw)
    g = jax.nn.silu(layer_norm(g, g_ln, b_ln))
    out = jnp.concatenate([attn, g], axis=-1) @ w_out
    return out, (ckv, kr)


def gqa_mixer(h, w_in, g_q, g_k, w_out, ctx):
    B, S, _ = h.shape
    q, k, v = jnp.split(h @ w_in, [MIX_C, MIX_C + GQA_KV_HEADS * GQA_HEAD_DIM], axis=-1)
    q = rms_norm(q.reshape(B, S, GQA_HEADS, GQA_HEAD_DIM), g_q)
    k = rms_norm(k.reshape(B, S, GQA_KV_HEADS, GQA_HEAD_DIM), g_k)
    v = v.reshape(B, S, GQA_KV_HEADS, GQA_HEAD_DIM)
    if ctx is None:
        keys, vals = k, v
    else:
        q = axial_rope(q)
        keys = jnp.concatenate([ctx[0], axial_rope(k)], axis=1)
        vals = jnp.concatenate([ctx[1], v], axis=1)
    grp = GQA_HEADS // GQA_KV_HEADS
    o = block_attention(q.reshape(B, S, GQA_KV_HEADS, grp, GQA_HEAD_DIM), keys, vals, GQA_HEAD_DIM ** -0.5)
    return o.reshape(B, S, MIX_C) @ w_out, (k, v)


def trunk(x, cond, ctx, p):
    e = jax.nn.silu(cond)
    saved_a, saved_c = [], []
    for l in range(DEPTH):
        mod = (e @ p['w_mod'][l] + p['b_mod'][l])[:, None, :]
        sh1, sc1, g1, shm, scm, gm, sh2, sc2, g2 = jnp.split(mod, N_MOD, axis=-1)
        h = rms_norm(x, p['g_ff1'][l]) * (1 + sc1) + sh1
        x = x + MACARON * g1 * swiglu(h, p['w_ff1_in'][l], p['w_ff1_out'][l])
        h = rms_norm(x, p['g_mix'][l]) * (1 + scm) + shm
        if l % 2 == 0:
            i = l // 2
            cc = None if ctx is None else (ctx[0][:, i], ctx[1][:, i])
            out, st = mla_conv_mixer(h, p['w_in_a'][i], p['g_q_lora'][i], p['w_q_up'][i], p['g_kv_lora'][i],
                                     p['w_kv_up'][i], p['w_dw'][i], p['b_dw'][i], p['g_conv_ln'][i],
                                     p['b_conv_ln'][i], p['w_out_a'][i], cc)
            saved_a.append(st)
        else:
            i = l // 2
            cc = None if ctx is None else (ctx[2][:, i], ctx[3][:, i])
            out, st = gqa_mixer(h, p['w_in_c'][i], p['g_q_head'][i], p['g_k_head'][i], p['w_out_c'][i], cc)
            saved_c.append(st)
        x = x + gm * out
        h = rms_norm(x, p['g_ff2'][l]) * (1 + sc2) + sh2
        x = x + MACARON * g2 * swiglu(h, p['w_ff2_in'][l], p['w_ff2_out'][l])
    return rms_norm(x, p['g_final']), saved_a, saved_c


def setup_inputs(seed: int = 0) -> dict:
    key = jax.random.key(seed)
    ks = iter(jax.random.split(key, 48))
    f32 = jnp.float32

    def nrm(shape, scale=1.0):
        return jax.random.normal(next(ks), shape, f32) * scale

    def gain(shape):
        return 1.0 + 0.05 * jax.random.normal(next(ks), shape, f32)

    return {
        'x_prompt': nrm((BATCH, SEQ, D_MODEL)),
        'x_sample': nrm((DEC_BATCH, DEC_SEQ, D_MODEL)),
        'cache_mla_ckv': nrm((DEC_BATCH, N_EVEN, PAST_LEN, KV_LORA)),
        'cache_mla_krope': nrm((DEC_BATCH, N_EVEN, PAST_LEN, QK_ROPE)),
        'cache_gqa_k': nrm((DEC_BATCH, N_ODD, PAST_LEN, GQA_KV_HEADS, GQA_HEAD_DIM)),
        'cache_gqa_v': nrm((DEC_BATCH, N_ODD, PAST_LEN, GQA_KV_HEADS, GQA_HEAD_DIM)),
        'c': nrm((DEC_BATCH, D_MODEL)),
        'c_ctx': nrm((D_MODEL,)),
        'g_ff1': gain((DEPTH, D_MODEL)),
        'w_ff1_in': nrm((DEPTH, D_MODEL, 2 * D_FF), D_MODEL ** -0.5),
        'w_ff1_out': nrm((DEPTH, D_FF, D_MODEL), D_FF ** -0.5),
        'g_mix': gain((DEPTH, D_MODEL)),
        'g_ff2': gain((DEPTH, D_MODEL)),
        'w_ff2_in': nrm((DEPTH, D_MODEL, 2 * D_FF), D_MODEL ** -0.5),
        'w_ff2_out': nrm((DEPTH, D_FF, D_MODEL), D_FF ** -0.5),
        'w_mod': nrm((DEPTH, D_MODEL, N_MOD * D_MODEL), D_MODEL ** -0.5),
        'b_mod': nrm((DEPTH, N_MOD * D_MODEL), 0.01),
        'w_in_a': nrm((N_EVEN, D_MODEL, IN_A), D_MODEL ** -0.5),
        'g_q_lora': gain((N_EVEN, Q_LORA)),
        'w_q_up': nrm((N_EVEN, Q_LORA, MLA_HEADS * (QK_NOPE + QK_ROPE)), Q_LORA ** -0.5),
        'g_kv_lora': gain((N_EVEN, KV_LORA)),
        'w_kv_up': nrm((N_EVEN, KV_LORA, MLA_HEADS * (QK_NOPE + V_HEAD)), KV_LORA ** -0.5),
        'w_dw': nrm((N_EVEN, CONV_W, CONV_CH), CONV_W ** -0.5),
        'b_dw': nrm((N_EVEN, CONV_CH), 0.01),
        'g_conv_ln': gain((N_EVEN, CONV_CH)),
        'b_conv_ln': nrm((N_EVEN, CONV_CH), 0.01),
        'w_out_a': nrm((N_EVEN, MIX_A, D_MODEL), MIX_A ** -0.5),
        'w_in_c': nrm((N_ODD, D_MODEL, IN_C), D_MODEL ** -0.5),
        'g_q_head': gain((N_ODD, GQA_HEAD_DIM)),
        'g_k_head': gain((N_ODD, GQA_HEAD_DIM)),
        'w_out_c': nrm((N_ODD, MIX_C, D_MODEL), MIX_C ** -0.5),
        'g_final': gain((D_MODEL,)),
    }


def reference(x_prompt, x_sample, cache_mla_ckv, cache_mla_krope, cache_gqa_k, cache_gqa_v, c, c_ctx,
              g_ff1, w_ff1_in, w_ff1_out, g_mix, g_ff2, w_ff2_in, w_ff2_out, w_mod, b_mod,
              w_in_a, g_q_lora, w_q_up, g_kv_lora, w_kv_up, w_dw, b_dw, g_conv_ln, b_conv_ln, w_out_a,
              w_in_c, g_q_head, g_k_head, w_out_c, g_final):
    p = dict(g_ff1=g_ff1, w_ff1_in=w_ff1_in, w_ff1_out=w_ff1_out, g_mix=g_mix, g_ff2=g_ff2,
             w_ff2_in=w_ff2_in, w_ff2_out=w_ff2_out, w_mod=w_mod, b_mod=b_mod,
             w_in_a=w_in_a, g_q_lora=g_q_lora, w_q_up=w_q_up, g_kv_lora=g_kv_lora, w_kv_up=w_kv_up,
             w_dw=w_dw, b_dw=b_dw, g_conv_ln=g_conv_ln, b_conv_ln=b_conv_ln, w_out_a=w_out_a,
             w_in_c=w_in_c, g_q_head=g_q_head, g_k_head=g_k_head, w_out_c=w_out_c, g_final=g_final)
    y_prompt, saved_a, saved_c = trunk(x_prompt, c_ctx[None, :], None, p)
    new_mla_ckv = jnp.stack([s[0] for s in saved_a], axis=1)
    new_mla_krope = jnp.stack([s[1] for s in saved_a], axis=1)
    new_gqa_k = jnp.stack([s[0] for s in saved_c], axis=1)
    new_gqa_v = jnp.stack([s[1] for s in saved_c], axis=1)
    y_sample, _, _ = trunk(x_sample, c, (cache_mla_ckv, cache_mla_krope, cache_gqa_k, cache_gqa_v), p)
    return (y_prompt, y_sample, new_mla_ckv, new_mla_krope, new_gqa_k, new_gqa_v)
```

```cpp
#include <hip/hip_runtime.h>
#include <hip/hip_cooperative_groups.h>
#include <cstdio>
#include <cstdint>
namespace cg = cooperative_groups;

#define DI __device__ __forceinline__

namespace pg8 {
#define PG8_LAS __attribute__((address_space(3)))
typedef unsigned short bf16_t;
typedef short bf16x8 __attribute__((ext_vector_type(8)));
typedef float f32x4 __attribute__((ext_vector_type(4)));
typedef unsigned u32x4 __attribute__((ext_vector_type(4)));
constexpr int BM = 256, BK = 64, HALF = 128, HTB = HALF * BK * 2, STAGE_BYTES = 8 * HTB, NXCD = 8, WGM = 8;

__host__ __device__ __forceinline__ int lds_byte(int r, int c) { const int st = (r >> 4) * 2 + (c >> 5), rr = r & 15, cc = c & 31, ob = rr * 64 + cc * 2; return st * 1024 + (ob ^ (((ob >> 9) & 1) << 5)); }
__host__ __device__ __forceinline__ void stage_rc(int b, int& R, int& C) { const int st = b / 1024, sb = b % 1024, swz = sb ^ (((sb >> 9) & 1) << 5); R = (st >> 1) * 16 + swz / 64; C = (st & 1) * 32 + (swz % 64) / 2; }
__host__ __device__ __forceinline__ int perm32(int rho) { const int n = rho >> 4, i = rho & 15; return 8 * (i >> 2) + 4 * n + (i & 3); }

struct Unit { int pm, pn; };
struct Gemm { const bf16_t* A; const bf16_t* Bt; int M, N, K; };

struct StaticOrder {
    int nM, nN, nwg, G, c;
    __host__ __device__ void init(int M, int N, int G_, int c_) { nM = M / BM; nN = N / BM; nwg = nM * nN; G = G_; c = c_; }
    __host__ __device__ bool next(int i, Unit& u) const {
        const long L = (long)i * G + c; if (L >= nwg) return false;
        int wgid = (int)L; { const int q = nwg / NXCD, r = nwg % NXCD, xcd = wgid % NXCD, off = wgid / NXCD; wgid = (xcd < r ? xcd * (q + 1) : r * (q + 1) + (xcd - r) * q) + off; }
        const int nig = WGM * nN, gid = wgid / nig, fm = gid * WGM, gsz = (nM - fm) < WGM ? (nM - fm) : WGM;
        u.pm = fm + ((wgid % nig) % gsz); u.pn = (wgid % nig) / gsz; return true;
    }
    __device__ __forceinline__ void a_ready(const Unit&) const {}
    __device__ __forceinline__ void done(const Unit&) const {}
};

__device__ __forceinline__ unsigned cvt_pk_bf16(float lo, float hi) { unsigned r; asm volatile("v_cvt_pk_bf16_f32 %0, %1, %2" : "=v"(r) : "v"(lo), "v"(hi)); return r; }

template <class Epi, class Sched, bool ALIGN_EPI = false, bool SP2 = false>
__device__ __forceinline__ void gemm_phase(PG8_LAS unsigned char* lds, const Gemm g, const Sched& S, const Epi& E) {
    int tid_l = threadIdx.x; asm volatile("" : "+v"(tid_l));
    const int tid = tid_l, wid = __builtin_amdgcn_readfirstlane(tid >> 6), lane = tid & 63, wr = wid >> 2, wc = wid & 3, fr = lane & 15, fq = lane >> 4;
    int K_l = g.K; asm volatile("" : "+s"(K_l)); const int K = K_l, nt = K / BK;
    unsigned voffA[2], voffB[2];
#pragma unroll
    for (int i = 0; i < 2; ++i) { int R, C; stage_rc(tid * 16 + i * 8192, R, C); const int Rb = Epi::PERM ? ((R & ~31) + perm32(R & 31)) : R;
        voffA[i] = (unsigned)(R * K + C) * 2u; voffB[i] = (unsigned)(Rb * K + C) * 2u; }
    const size_t kstep = (size_t)(BK * 2);
    const size_t hstep = (size_t)HALF * K * 2;
    const size_t tstep = 2 * hstep;
    const unsigned ldsw = (unsigned)wid * 1024u;
    const int aoff = lds_byte(wr * 64 + fr, fq * 8), boff = lds_byte(wc * 32 + fr, fq * 8);
#define PG8_SA(b, h) (((b) * 2 + (h)) * HTB)
#define PG8_SB(b, h) ((4 + (b) * 2 + (h)) * HTB)
#define PG8_STAGE(bufoff, gbase, voff) do { _Pragma("unroll") for (int _i = 0; _i < 2; ++_i) \
        __builtin_amdgcn_global_load_lds((const unsigned*)((const char*)(gbase) + (voff)[_i]), (PG8_LAS unsigned*)(lds + (bufoff) + ldsw + _i * 8192), 16, 0, 0); } while (0)
#define PG8_LDA(dst, b, h) do { _Pragma("unroll") for (int m = 0; m < 4; ++m) _Pragma("unroll") for (int k = 0; k < 2; ++k) dst[m][k] = *(const PG8_LAS bf16x8*)(lds + PG8_SA(b, h) + aoff + m * 2048 + k * 1024); } while (0)
#define PG8_LDB(dst, b, h) do { _Pragma("unroll") for (int n = 0; n < 2; ++n) _Pragma("unroll") for (int k = 0; k < 2; ++k) dst[n][k] = *(const PG8_LAS bf16x8*)(lds + PG8_SB(b, h) + boff + n * 2048 + k * 1024); } while (0)
#define PG8_MMA(ai, bj, At, Bt) do { __builtin_amdgcn_s_setprio(1); _Pragma("unroll") for (int m = 0; m < 4; ++m) _Pragma("unroll") for (int n = 0; n < 2; ++n) _Pragma("unroll") for (int k = 0; k < 2; ++k) \
        acc[ai][bj][m][n] = __builtin_amdgcn_mfma_f32_16x16x32_bf16(Bt[n][k], At[m][k], acc[ai][bj][m][n], 0, 0, 0); __builtin_amdgcn_s_setprio(0); } while (0)
#define PG8_WAIT_V(n) asm volatile("s_waitcnt vmcnt(" #n ")" ::: "memory")
#define PG8_WAIT_L(n) asm volatile("s_waitcnt lgkmcnt(" #n ")" ::: "memory")
#define PG8_BAR __builtin_amdgcn_s_barrier()
#define PG8_SCHED __builtin_amdgcn_sched_barrier(0)
    Unit cur, nxt; int ui = 0;
    if (!S.next(0, cur)) return;
    f32x4 acc[2][2][4][2];
#pragma unroll
    for (int a = 0; a < 2; ++a)
#pragma unroll
        for (int b = 0; b < 2; ++b)
#pragma unroll
            for (int m = 0; m < 4; ++m)
#pragma unroll
                for (int n = 0; n < 2; ++n) acc[a][b][m][n] = (f32x4){0.f, 0.f, 0.f, 0.f};
    bf16x8 At[4][2], B0[2][2], B1[2][2];
    const char* cA = (const char*)g.A + (size_t)cur.pm * tstep; const char* cB = (const char*)g.Bt + (size_t)cur.pn * tstep;
    S.a_ready(cur);
    if constexpr (SP2) {
        PG8_STAGE(PG8_SB(0, 0), cB, voffB); PG8_STAGE(PG8_SB(0, 1), cB + hstep, voffB); PG8_STAGE(PG8_SA(0, 0), cA, voffA); PG8_STAGE(PG8_SA(0, 1), cA + hstep, voffA);
        if (wr == 1) PG8_BAR;
        PG8_WAIT_V(2); PG8_BAR;
        PG8_STAGE(PG8_SB(1, 0), cB + kstep, voffB); PG8_STAGE(PG8_SA(1, 0), cA + kstep, voffA); PG8_STAGE(PG8_SB(1, 1), cB + hstep + kstep, voffB);
        PG8_WAIT_V(6); PG8_BAR;
    } else {
        PG8_STAGE(PG8_SB(0, 0), cB, voffB); PG8_STAGE(PG8_SA(0, 0), cA, voffA); PG8_STAGE(PG8_SB(0, 1), cB + hstep, voffB); PG8_STAGE(PG8_SA(0, 1), cA + hstep, voffA);
        if (wr == 1) PG8_BAR;
        PG8_WAIT_V(4); PG8_BAR;
        PG8_STAGE(PG8_SB(1, 0), cB + kstep, voffB); PG8_STAGE(PG8_SA(1, 0), cA + kstep, voffA); PG8_STAGE(PG8_SB(1, 1), cB + hstep + kstep, voffB);
        PG8_WAIT_V(6); PG8_BAR;
    }
    for (;;) {
        const bool has_next = S.next(ui + 1, nxt);
        const char* nA = has_next ? (const char*)g.A + (size_t)nxt.pm * tstep : cA; const char* nB = has_next ? (const char*)g.Bt + (size_t)nxt.pn * tstep : cB;
        for (int t = 0; t < nt; t += 2) {
            const bool last = (t == nt - 2);
            const char* a1 = cA + (size_t)(t + 1) * kstep;
            const char* a2 = last ? nA : cA + (size_t)(t + 2) * kstep; const char* b2 = last ? nB : cB + (size_t)(t + 2) * kstep;
            const char* a3 = a2 + kstep; const char* b3 = b2 + kstep;
            if (last && has_next) S.a_ready(nxt);
            if constexpr (SP2) {
            PG8_LDB(B0, 0, 0); PG8_LDB(B1, 0, 1); PG8_SCHED; PG8_LDA(At, 0, 0); PG8_STAGE(PG8_SA(1, 1), a1 + hstep, voffA);
            PG8_WAIT_V(8); PG8_WAIT_L(0); PG8_BAR; PG8_MMA(0, 0, At, B0); PG8_MMA(0, 1, At, B1); PG8_BAR; PG8_SCHED;
            PG8_LDA(At, 0, 1); PG8_STAGE(PG8_SB(0, 0), b2, voffB); PG8_STAGE(PG8_SB(0, 1), b2 + hstep, voffB); PG8_STAGE(PG8_SA(0, 0), a2, voffA);
            PG8_WAIT_V(8); PG8_WAIT_L(0); PG8_BAR; PG8_MMA(1, 0, At, B0); PG8_MMA(1, 1, At, B1); PG8_BAR; PG8_SCHED;
            PG8_LDB(B0, 1, 0); PG8_LDB(B1, 1, 1); PG8_SCHED; PG8_LDA(At, 1, 0); PG8_STAGE(PG8_SA(0, 1), a2 + hstep, voffA);
            PG8_WAIT_V(8); PG8_WAIT_L(0); PG8_BAR; PG8_MMA(0, 0, At, B0); PG8_MMA(0, 1, At, B1); PG8_BAR; PG8_SCHED;
            PG8_LDA(At, 1, 1); PG8_STAGE(PG8_SB(1, 0), b3, voffB); PG8_STAGE(PG8_SB(1, 1), b3 + hstep, voffB); PG8_STAGE(PG8_SA(1, 0), a3, voffA);
            PG8_WAIT_V(8); PG8_WAIT_L(0); PG8_BAR; PG8_MMA(1, 0, At, B0); PG8_MMA(1, 1, At, B1); PG8_BAR; PG8_SCHED;
            } else {
            PG8_LDB(B0, 0, 0); PG8_SCHED; PG8_LDA(At, 0, 0); PG8_STAGE(PG8_SA(1, 1), a1 + hstep, voffA);
            PG8_WAIT_L(8); PG8_BAR; PG8_WAIT_L(0); PG8_MMA(0, 0, At, B0); PG8_BAR; PG8_SCHED;
            PG8_LDB(B1, 0, 1); PG8_STAGE(PG8_SB(0, 0), b2, voffB);
            PG8_BAR; PG8_WAIT_L(0); PG8_MMA(0, 1, At, B1); PG8_BAR;
            PG8_LDA(At, 0, 1); PG8_STAGE(PG8_SA(0, 0), a2, voffA);
            PG8_BAR; PG8_WAIT_L(0); PG8_MMA(1, 0, At, B0); PG8_BAR; PG8_SCHED;
            PG8_STAGE(PG8_SB(0, 1), b2 + hstep, voffB);
            PG8_WAIT_V(6); PG8_BAR; PG8_MMA(1, 1, At, B1); PG8_BAR;
            PG8_LDB(B0, 1, 0); PG8_SCHED; PG8_LDA(At, 1, 0); PG8_STAGE(PG8_SA(0, 1), a2 + hstep, voffA);
            PG8_WAIT_L(8); PG8_BAR; PG8_WAIT_L(0); PG8_MMA(0, 0, At, B0); PG8_BAR; PG8_SCHED;
            PG8_LDB(B1, 1, 1); PG8_STAGE(PG8_SB(1, 0), b3, voffB);
            PG8_BAR; PG8_WAIT_L(0); PG8_MMA(0, 1, At, B1); PG8_BAR;
            PG8_LDA(At, 1, 1); PG8_STAGE(PG8_SA(1, 0), a3, voffA);
            PG8_BAR; PG8_WAIT_L(0); PG8_MMA(1, 0, At, B0); PG8_BAR; PG8_SCHED;
            PG8_STAGE(PG8_SB(1, 1), b3 + hstep, voffB);
            PG8_WAIT_V(6); PG8_BAR; PG8_MMA(1, 1, At, B1); PG8_BAR;
            }
        }
        if constexpr (ALIGN_EPI) { if (wr == 0) PG8_BAR; }
        E(acc, cur, wr, wc, fr, fq); S.done(cur);
        if (!has_next) break;
#pragma unroll
        for (int a = 0; a < 2; ++a)
#pragma unroll
            for (int b = 0; b < 2; ++b)
#pragma unroll
                for (int m = 0; m < 4; ++m)
#pragma unroll
                    for (int n = 0; n < 2; ++n) acc[a][b][m][n] = (f32x4){0.f, 0.f, 0.f, 0.f};
        cur = nxt; cA = nA; cB = nB; ++ui;
        if constexpr (ALIGN_EPI) { if (wr == 1) PG8_BAR; }
    }
    PG8_WAIT_V(0);
    if constexpr (!ALIGN_EPI) { if (wr == 0) PG8_BAR; }
    PG8_BAR;
#undef PG8_SA
#undef PG8_SB
#undef PG8_STAGE
#undef PG8_LDA
#undef PG8_LDB
#undef PG8_MMA
#undef PG8_WAIT_V
#undef PG8_WAIT_L
#undef PG8_BAR
#undef PG8_SCHED
}
}

using pg8::bf16_t; using pg8::bf16x8; using pg8::f32x4; using pg8::u32x4; using pg8::Unit; using pg8::cvt_pk_bf16;
typedef float f32x16 __attribute__((ext_vector_type(16)));
typedef float f32x2 __attribute__((ext_vector_type(2)));
typedef unsigned u32x2 __attribute__((ext_vector_type(2)));
typedef short s16x4 __attribute__((ext_vector_type(4)));

constexpr int DM = 1024, NTOK = 16384, NPR = 8192, FF = 2816, NMOD = 9216;
constexpr int INA_P = 1792, INC = 1536;
constexpr float EPS = 1e-6f;
constexpr float LOG2E = 1.4426950408889634f;
constexpr int GSZ = 512;

constexpr size_t MiB = 1u << 20;
constexpr size_t WS_MOD = 64 * 1024, WS_ROPE_A = 512 * 1024, WS_ROPE_C = 512 * 1024 + 8192;
constexpr size_t WS_WFFIN = 1 * MiB, WFFIN_SZ = 11 * MiB;
constexpr size_t WS_WFFOUT = 45 * MiB, WFFOUT_SZ = 5 * MiB + 512 * 1024;
constexpr size_t WS_WINA = 67 * MiB, WS_WQUP = 70 * MiB + 512 * 1024, WS_WKVUP = 71 * MiB + 512 * 1024, WS_WOUTA = 72 * MiB, WS_WINC = 74 * MiB, WS_WOUTC = 77 * MiB;
constexpr size_t WS_HB = 79 * MiB;
constexpr size_t WS_HID = 111 * MiB;
constexpr size_t WS_RAW = 111 * MiB;
constexpr size_t WS_QB0 = 111 * MiB, WS_MIX0 = 167 * MiB;
constexpr size_t WS_QB1 = 159 * MiB, WS_MIX1 = 199 * MiB;
constexpr size_t WS_CQN = 199 * MiB, WS_CKVN = 211 * MiB;
constexpr size_t WS_KB0 = 220 * MiB, WS_VT0 = 238 * MiB, WS_KB1 = 256 * MiB, WS_VT1 = 265 * MiB, WS_KR = 274 * MiB;
constexpr size_t WS_SS = 276 * MiB, WS_BIAS = 278 * MiB, WS_GM = 279 * MiB, WS_END = 280 * MiB;

constexpr size_t OUT_CKV = 16777216, OUT_KROPE = 18874368, OUT_GK = 19136512, OUT_GV = 21233664;

struct Args { const float* in[32]; float* out; unsigned char* ws; };


constexpr int LDS_PTAB = 131072 + 64, LDS_RED = 131072 + 512;
template <class T, int I> DI T* ldptr() {
    u32x2 v;
    asm volatile("ds_read_b64 %0, %1 offset:%2\n\ts_waitcnt lgkmcnt(0)" : "=v"(v) : "v"(131072u), "n"(64 + 8 * I) : "memory");
    return (T*)(((unsigned long long)(unsigned)__builtin_amdgcn_readfirstlane((int)v.y) << 32) | (unsigned long long)(unsigned)__builtin_amdgcn_readfirstlane((int)v.x));
}
#define INP(i) ldptr<const float, i>()
#define OUTP() ldptr<float, 32>()
#define WSP() ldptr<unsigned char, 33>()

typedef __bf16 bf16x2_t __attribute__((ext_vector_type(2)));
DI unsigned cvtpk_s(float lo, float hi) { f32x2 v = {lo, hi}; bf16x2_t b = __builtin_convertvector(v, bf16x2_t); return __builtin_bit_cast(unsigned, b); }

DI unsigned pk2(float lo, float hi) { return cvtpk_s(lo, hi); }
DI float bf2f(unsigned short b) { return __uint_as_float(((unsigned)b) << 16); }
DI float bflo(unsigned w) { return __uint_as_float(w << 16); }
DI float bfhi(unsigned w) { return __uint_as_float(w & 0xffff0000u); }
DI float wave_sum(float v) {
#pragma unroll
    for (int o = 1; o < 64; o <<= 1) v += __shfl_xor(v, o);
    return v;
}
DI float fast_rcp(float x) { return __builtin_amdgcn_rcpf(x); }
DI float silu_f(float a) { return a * fast_rcp(1.f + __expf(-a)); }
DI float sigmoid_f(float a) { return fast_rcp(1.f + __expf(-a)); }

struct EpiSwiglu { static constexpr bool PERM = true, AFTER_DRAIN = false;
    bf16_t* H; const float* ss; const float* bias;
    DI void operator()(const f32x4 (&acc)[2][2][4][2], const Unit& u, int wr, int wc, int fr, int fq) const {
        const int row0 = u.pm * 256 + wr * 64 + fr, col0 = u.pn * 128 + wc * 32 + 8 * fq;
        const int cond = u.pm < 32 ? 4 : ((u.pm - 32) >> 3);
        const float* bp = bias + (size_t)cond * 5632 + u.pn * 256 + wc * 32 + 8 * fq;
        const f32x4 ba0 = *(const f32x4*)(bp), ba1 = *(const f32x4*)(bp + 4), bb0 = *(const f32x4*)(bp + 128), bb1 = *(const f32x4*)(bp + 132);
#pragma unroll
        for (int ai = 0; ai < 2; ++ai)
#pragma unroll
            for (int m = 0; m < 4; ++m) {
                const int row = row0 + ai * 128 + m * 16;
                const f32x4 sp4 = *(const f32x4*)(ss + (size_t)row * 4); const float r = rsqrtf(((sp4.x + sp4.y) + (sp4.z + sp4.w)) * (1.f / DM) + EPS);
                bf16_t* p = H + (size_t)row * FF + col0;
                float h[8];
#pragma unroll
                for (int i = 0; i < 4; ++i) { const float a0 = acc[ai][0][m][0][i] * r + ba0[i], b0 = acc[ai][1][m][0][i] * r + bb0[i]; h[i] = silu_f(a0) * b0;
                                              const float a1 = acc[ai][0][m][1][i] * r + ba1[i], b1 = acc[ai][1][m][1][i] * r + bb1[i]; h[4 + i] = silu_f(a1) * b1; }
                u32x4 w; w.x = pk2(h[0], h[1]); w.y = pk2(h[2], h[3]); w.z = pk2(h[4], h[5]); w.w = pk2(h[6], h[7]);
                *(u32x4*)p = w;
            }
    }
};
struct EpiResid { static constexpr bool PERM = true, AFTER_DRAIN = false;
    const float* xlo; const float* xhi; bf16_t* X; const float* gate;
    bf16_t* XG; const float* gmn; float* ss; float coef; int wxf; int skipx; int xbf;
    DI void operator()(const f32x4 (&acc)[2][2][4][2], const Unit& u, int wr, int wc, int fr, int fq) const {
        const int row0 = u.pm * 256 + wr * 64 + fr;
        const int cond = u.pm < 32 ? 4 : ((u.pm - 32) >> 3);
        const float* gp = gate + (size_t)cond * NMOD; const float* xo = u.pm < 32 ? xlo : xhi;
        const float* gm = gmn + cond * 1024;
        const bool wx = wxf != 0;
        float rs[2][4];
#pragma unroll
        for (int ai = 0; ai < 2; ++ai)
#pragma unroll
            for (int m = 0; m < 4; ++m) rs[ai][m] = 0.f;
#pragma unroll
        for (int bj = 0; bj < 2; ++bj) {
            const int c = u.pn * 256 + bj * 128 + wc * 32 + 8 * fq;
            const f32x4 gv0 = *(const f32x4*)(gp + c) * coef, gv1 = *(const f32x4*)(gp + c + 4) * coef;
            f32x4 gm0 = (f32x4){0.f, 0.f, 0.f, 0.f}, gm1 = gm0; if (wx) { gm0 = *(const f32x4*)(gm + c); gm1 = *(const f32x4*)(gm + c + 4); }
#pragma unroll
            for (int ai = 0; ai < 2; ++ai)
#pragma unroll
                for (int m = 0; m < 4; ++m) { const size_t off = (size_t)(row0 + ai * 128 + m * 16) * DM + c;
                    f32x4 x0, x1;
                    if (xbf) { const u32x4 xw = *(const u32x4*)(X + off); x0 = (f32x4){bflo(xw.x), bfhi(xw.x), bflo(xw.y), bfhi(xw.y)}; x1 = (f32x4){bflo(xw.z), bfhi(xw.z), bflo(xw.w), bfhi(xw.w)}; }
                    else { x0 = *(const f32x4*)(xo + off); x1 = *(const f32x4*)(xo + off + 4); }
                    const f32x4 n0 = x0 + gv0 * acc[ai][bj][m][0], n1 = x1 + gv1 * acc[ai][bj][m][1];
                    if (!skipx) { u32x4 xs; xs.x = pk2(n0.x, n0.y); xs.y = pk2(n0.z, n0.w); xs.z = pk2(n1.x, n1.y); xs.w = pk2(n1.z, n1.w); *(u32x4*)(X + off) = xs; }
                    if (wx) { rs[ai][m] += ((n0.x * n0.x + n0.y * n0.y) + (n0.z * n0.z + n0.w * n0.w)) + ((n1.x * n1.x + n1.y * n1.y) + (n1.z * n1.z + n1.w * n1.w));
                        const f32x4 y0 = n0 * gm0, y1 = n1 * gm1; u32x4 w; w.x = pk2(y0.x, y0.y); w.y = pk2(y0.z, y0.w); w.z = pk2(y1.x, y1.y); w.w = pk2(y1.z, y1.w); *(u32x4*)(XG + off) = w; } }
        }
        if (wx) {
            extern __shared__ __attribute__((aligned(16))) unsigned char lds_raw[];
            __attribute__((address_space(3))) float* red = (__attribute__((address_space(3))) float*)((__attribute__((address_space(3))) unsigned char*)lds_raw + LDS_RED);
#pragma unroll
            for (int ai = 0; ai < 2; ++ai)
#pragma unroll
                for (int m = 0; m < 4; ++m) { float v = rs[ai][m]; v += __shfl_xor(v, 16); v += __shfl_xor(v, 32); if (fq == 0) red[wc * 256 + ai * 128 + wr * 64 + m * 16 + fr] = v; }
            asm volatile("s_waitcnt lgkmcnt(0)" ::: "memory"); __builtin_amdgcn_s_barrier(); asm volatile("" ::: "memory");
            const int t = (wr * 4 + wc) * 64 + fq * 16 + fr;
            if (t < 256) ss[((size_t)u.pm * 256 + t) * 4 + u.pn] = (red[t] + red[256 + t]) + (red[512 + t] + red[768 + t]);
            asm volatile("s_waitcnt lgkmcnt(0)" ::: "memory"); __builtin_amdgcn_s_barrier(); asm volatile("" ::: "memory");
        }
    }
};
template <bool NORM> struct EpiStore { static constexpr bool PERM = true, AFTER_DRAIN = false;
    bf16_t* O; int ldc; float sc; const float* ss; const float* bias;
    DI void operator()(const f32x4 (&acc)[2][2][4][2], const Unit& u, int wr, int wc, int fr, int fq) const {
        const int row0 = u.pm * 256 + wr * 64 + fr, col0 = u.pn * 256 + wc * 32 + 8 * fq;
        const int cond = u.pm < 32 ? 4 : ((u.pm - 32) >> 3);
        f32x4 bv[2][2];
#pragma unroll
        for (int bj = 0; bj < 2; ++bj)
#pragma unroll
            for (int n = 0; n < 2; ++n) bv[bj][n] = NORM ? *(const f32x4*)(bias + (size_t)cond * 5632 + col0 + bj * 128 + 4 * n) : (f32x4){0.f, 0.f, 0.f, 0.f};
#pragma unroll
        for (int ai = 0; ai < 2; ++ai)
#pragma unroll
            for (int m = 0; m < 4; ++m) {
                const int row = row0 + ai * 128 + m * 16;
                float r = sc; if (NORM) { const f32x4 sp4 = *(const f32x4*)(ss + (size_t)row * 4); r = rsqrtf(((sp4.x + sp4.y) + (sp4.z + sp4.w)) * (1.f / DM) + EPS); }
#pragma unroll
                for (int bj = 0; bj < 2; ++bj) {
                    const f32x4 v0 = acc[ai][bj][m][0] * r + bv[bj][0], v1 = acc[ai][bj][m][1] * r + bv[bj][1];
                    u32x4 w; w.x = pk2(v0[0], v0[1]); w.y = pk2(v0[2], v0[3]); w.z = pk2(v1[0], v1[1]); w.w = pk2(v1[2], v1[3]);
                    *(u32x4*)(O + (size_t)row * ldc + col0 + bj * 128) = w;
                }
            }
    }
};
struct EpiKVup { static constexpr bool PERM = true, AFTER_DRAIN = false;
    bf16_t* KB; bf16_t* VT;
    DI void operator()(const f32x4 (&acc)[2][2][4][2], const Unit& u, int wr, int wc, int fr, int fq) const {
        const int row0 = u.pm * 256 + wr * 64 + fr;
        unsigned kb0, Sk; int key0;
        if (u.pm < 32) { const int s = u.pm; key0 = 0; Sk = 256; kb0 = (unsigned)(s * 8) * 256u; }
        else { int b, k; if (u.pm < 64) { const int t = (u.pm - 32) * 256; b = t >> 11; k = 512 + (t & 2047); } else { const int t = (u.pm - 64) * 256; b = t >> 9; k = t & 511; }
            key0 = k; Sk = 2560; kb0 = 32u * 8u * 256u + (unsigned)(b * 8) * 2560u; }
        const int keyl = key0 + wr * 64 + fr;
#pragma unroll
        for (int bj = 0; bj < 2; ++bj) {
            const unsigned h = u.pn * 2 + bj;
#pragma unroll
            for (int ai = 0; ai < 2; ++ai)
#pragma unroll
                for (int m = 0; m < 4; ++m) {
                    const unsigned key = keyl + ai * 128 + m * 16;
                    const f32x4 v0 = acc[ai][bj][m][0], v1 = acc[ai][bj][m][1];
                    const unsigned a = cvtpk_s(v0[0], v0[1]), b2 = cvtpk_s(v0[2], v0[3]), c = cvtpk_s(v1[0], v1[1]), d = cvtpk_s(v1[2], v1[3]);
                    { u32x4 w; w.x = a; w.y = b2; w.z = c; w.w = d;
                      bf16_t* dst = (wc < 2) ? KB : VT;
                      *(u32x4*)(dst + (size_t)((kb0 + h * Sk + key) * 64u + (wc & 1) * 32 + 8 * fq)) = w; }
                    asm volatile("" ::: "memory");
                }
        }
    }
};

DI void transpose_item(const float* W, int K, int N, bf16_t* WT, bool ffmode, float* scr, int item, int lane) {
    const int nblk = N / 32, kb = item / nblk, nb = item % nblk, k0 = 64 * kb, n0 = 32 * nb;
    const int lk = lane >> 3, ln = (lane & 7) * 4;
    f32x4 v[8];
#pragma unroll
    for (int i = 0; i < 8; ++i) v[i] = __builtin_nontemporal_load((const f32x4*)(W + (size_t)(k0 + lk + 8 * i) * N + n0 + ln));
#pragma unroll
    for (int i = 0; i < 8; ++i) { float* d = scr + (lk + 8 * i) * 33 + ln; d[0] = v[i].x; d[1] = v[i].y; d[2] = v[i].z; d[3] = v[i].w; }
    asm volatile("s_waitcnt lgkmcnt(0)" ::: "memory");
    int rbase = n0;
    if (ffmode) { const bool isb = n0 >= FF; const int j0 = isb ? n0 - FF : n0; rbase = (j0 >> 7) * 256 + (isb ? 128 : 0) + (j0 & 127); }
    const int c = lane & 7;
#pragma unroll
    for (int j = 0; j < 4; ++j) { const int n = (lane >> 3) + 8 * j; const float* s = scr + (8 * c) * 33 + n;
        u32x4 o; o.x = pk2(s[0 * 33], s[1 * 33]); o.y = pk2(s[2 * 33], s[3 * 33]); o.z = pk2(s[4 * 33], s[5 * 33]); o.w = pk2(s[6 * 33], s[7 * 33]);
        *(u32x4*)(WT + (size_t)(rbase + n) * K + k0 + 8 * c) = o; }
    asm volatile("s_waitcnt lgkmcnt(0)" ::: "memory");
}

DI void transpose_set(int set, char* lds, int widx, int nw, int lane, int wave) {
    unsigned char* ws = WSP(); asm volatile("" : "+s"(ws));
    float* scr = (float*)(lds + 61440 + wave * 8704);
    constexpr int I_FI = 16 * 176, I_FO = 44 * 32, I_INA = 16 * 53, I_QU = 6 * 24, I_KV = 4 * 32, I_OA = 16 * 32, I_IC = 16 * 48, I_OC = 16 * 32;
    const int f = set, l = f >> 1, wh = f & 1;
    const int nextra = (set == 0) ? (I_INA + I_QU + I_KV + I_OA) : (set == 2 ? I_IC + I_OC : 0);
    const int nitems = I_FI + I_FO + nextra;
    for (int it = widx; it < nitems; it += nw) {
        int r = it;
        if (r < I_FI) { transpose_item((wh ? INP(13) : INP(9)) + (size_t)l * DM * 2 * FF, DM, 2 * FF, (bf16_t*)(ws + WS_WFFIN + f * WFFIN_SZ), true, scr, r, lane); continue; } r -= I_FI;
        if (r < I_FO) { transpose_item((wh ? INP(14) : INP(10)) + (size_t)l * FF * DM, FF, DM, (bf16_t*)(ws + WS_WFFOUT + f * WFFOUT_SZ), false, scr, r, lane); continue; } r -= I_FO;
        if (set == 0) {
            if (r < I_INA) { transpose_item(INP(17), DM, 1696, (bf16_t*)(ws + WS_WINA), false, scr, r, lane); continue; } r -= I_INA;
            if (r < I_QU) { transpose_item(INP(19), 384, 768, (bf16_t*)(ws + WS_WQUP), false, scr, r, lane); continue; } r -= I_QU;
            if (r < I_KV) { transpose_item(INP(21), 256, 1024, (bf16_t*)(ws + WS_WKVUP), false, scr, r, lane); continue; } r -= I_KV;
            transpose_item(INP(26), DM, DM, (bf16_t*)(ws + WS_WOUTA), false, scr, r, lane);
        } else {
            if (r < I_IC) { transpose_item(INP(27), DM, INC, (bf16_t*)(ws + WS_WINC), false, scr, r, lane); continue; } r -= I_IC;
            transpose_item(INP(30), DM, DM, (bf16_t*)(ws + WS_WOUTC), false, scr, r, lane);
        }
    }
}
DI void bias_rows(int k, int lane, int gw, int NGW) {
    unsigned char* ws = WSP(); asm volatile("" : "+s"(ws));
    const float* MOD = (const float*)(ws + WS_MOD);
    float* BIAS = (float*)(ws + WS_BIAS);
    const int l = k / 3, w3 = k % 3;
    const int Nk = (w3 == 1) ? (l ? INC : INA_P) : 2 * FF;
    const bf16_t* Wt = (const bf16_t*)(ws + (w3 == 1 ? (l ? WS_WINC : WS_WINA) : WS_WFFIN + (size_t)(2 * l + (w3 == 2 ? 1 : 0)) * WFFIN_SZ));
    float shv[5][16];
#pragma unroll
    for (int c = 0; c < 5; ++c) { const float* sp = MOD + (size_t)(l * 5 + c) * NMOD + (3 * w3) * 1024;
#pragma unroll
        for (int h = 0; h < 2; ++h) { const f32x4 s0 = *(const f32x4*)(sp + h * 512 + lane * 8), s1 = *(const f32x4*)(sp + h * 512 + lane * 8 + 4);
#pragma unroll
            for (int i = 0; i < 4; ++i) { shv[c][h * 8 + i] = s0[i]; shv[c][h * 8 + 4 + i] = s1[i]; } } }
    for (int row = gw; row < Nk; row += NGW) {
        const u32x4 w0 = *(const u32x4*)(Wt + (size_t)row * DM + lane * 8), w1 = *(const u32x4*)(Wt + (size_t)row * DM + 512 + lane * 8);
        float wv[16];
#pragma unroll
        for (int i = 0; i < 4; ++i) { wv[2 * i] = bflo(w0[i]); wv[2 * i + 1] = bfhi(w0[i]); wv[8 + 2 * i] = bflo(w1[i]); wv[8 + 2 * i + 1] = bfhi(w1[i]); }
#pragma unroll
        for (int c = 0; c < 5; ++c) { float d = 0.f;
#pragma unroll
            for (int i = 0; i < 16; ++i) d += wv[i] * shv[c][i];
            d = wave_sum(d);
            if (lane == 0) BIAS[(size_t)(k * 5 + c) * 5632 + row] = d; }
    }
}
#define FRESH_IDS int tid_l = threadIdx.x; asm volatile("" : "+v"(tid_l)); const int tid = tid_l, lane = tid & 63, wave = __builtin_amdgcn_readfirstlane(tid >> 6); (void)tid; (void)lane; (void)wave;
DI void phase0(char* lds) {
    FRESH_IDS
    unsigned char* ws = WSP(); asm volatile("" : "+s"(ws));
    const int G = gridDim.x;
    {
        float* eL = (float*)lds;
        float* part = (float*)(lds + 20480);
        float* MOD = (float*)(ws + WS_MOD);
        bool have = false;
        for (int task = blockIdx.x; task < 288; task += G) {
            if (!have) {
                for (int idx = tid; idx < 5120; idx += GSZ) { const int c = idx >> 10, k = idx & 1023; const float v = (c < 4) ? INP(6)[c * 1024 + k] : INP(7)[k]; eL[idx] = silu_f(v); }
                have = true;
            }
            __syncthreads();
            const int kh = task & 1, t2 = task >> 1, l = t2 / 72, n0 = (t2 % 72) * 128;
            const int kbase = kh * 512 + wave * 64;
            const float* wp = INP(15) + ((size_t)l * 1024 + kbase) * NMOD + n0 + 2 * lane;
            f32x2 acc[5];
#pragma unroll
            for (int c = 0; c < 5; ++c) acc[c] = (f32x2){0.f, 0.f};
            for (int k = 0; k < 64; k += 8) {
                f32x2 wv[8];
#pragma unroll
                for (int j = 0; j < 8; ++j) wv[j] = __builtin_nontemporal_load((const f32x2*)(wp + (size_t)(k + j) * NMOD));
#pragma unroll
                for (int j = 0; j < 8; ++j)
#pragma unroll
                    for (int c = 0; c < 5; ++c) { const float e = eL[c * 1024 + kbase + k + j]; acc[c] += wv[j] * e; }
            }
#pragma unroll
            for (int c = 0; c < 5; ++c) *(f32x2*)(part + (wave * 5 + c) * 128 + 2 * lane) = acc[c];
            __syncthreads();
            for (int idx = tid; idx < 640; idx += GSZ) { const int c = idx >> 7, n = idx & 127; float sacc = (kh == 0) ? INP(16)[l * NMOD + n0 + n] : 0.f;
#pragma unroll
                for (int w = 0; w < 8; ++w) sacc += part[(w * 5 + c) * 128 + n];
                atomicAdd(MOD + (size_t)(l * 5 + c) * NMOD + n0 + n, sacc); }
        }
        __syncthreads();
    }
    transpose_set(0, lds, blockIdx.x * 8 + wave, G * 8, lane, wave);
    {
        const int gt = blockIdx.x * GSZ + tid, NT = G * GSZ;
        { u32x4* z = (u32x4*)(ws + WS_WINA + (size_t)1696 * DM * 2); for (int i = gt; i < 96 * DM * 2 / 16; i += NT) z[i] = (u32x4){0u, 0u, 0u, 0u}; }
        { bf16_t* dst = (bf16_t*)(ws + WS_CKVN) + (size_t)NTOK * 256;
          for (int i = gt; i < 2048 * 256 / 4; i += NT) { const f32x4 v = *(const f32x4*)(INP(2) + (size_t)i * 4); u32x2 w; w.x = pk2(v[0], v[1]); w.y = pk2(v[2], v[3]); *(u32x2*)(dst + (size_t)i * 4) = w; } }
        { bf16_t* dst = (bf16_t*)(ws + WS_KR) + (size_t)NPR * 32;
          for (int i = gt; i < 2048 * 32 / 4; i += NT) { const int e = i * 4, b = e >> 14, rem = e & 16383; const f32x4 v = *(const f32x4*)(INP(3) + e); u32x2 w; w.x = pk2(v[0], v[1]); w.y = pk2(v[2], v[3]);
              *(u32x2*)(dst + (size_t)b * 2560 * 32 + rem) = w; } }
        { bf16_t* dst = (bf16_t*)(ws + WS_KB1) + (size_t)32 * 4 * 256 * 64;
          for (int i = gt; i < 2048 * 256 / 4; i += NT) { const int e = i * 4, d = e & 63, kvh = (e >> 6) & 3, key = (e >> 8) & 511, b = e >> 17; const f32x4 v = *(const f32x4*)(INP(4) + e);
              u32x2 w; w.x = pk2(v[0], v[1]); w.y = pk2(v[2], v[3]); *(u32x2*)(dst + ((size_t)(b * 4 + kvh) * 2560 + key) * 64 + d) = w; } }
        { bf16_t* dst = (bf16_t*)(ws + WS_VT1) + (size_t)32 * 4 * 256 * 64;
          for (int i = gt; i < 2048 * 256 / 4; i += NT) { const int e = i * 4, d = e & 63, kvh = (e >> 6) & 3, key = (e >> 8) & 511, b = e >> 17; const f32x4 v = *(const f32x4*)(INP(5) + e);
              u32x2 w; w.x = pk2(v[0], v[1]); w.y = pk2(v[2], v[3]); *(u32x2*)(dst + ((size_t)(b * 4 + kvh) * 2560 + key) * 64 + d) = w; } }
        if (gt < 64 * 24) {
            const int pos = gt / 24, fi = gt % 24; const bool isA = fi < 8; const int f = isA ? fi : fi - 8;
            const double c16 = 0.5623413251903491;
            double inv = 1.0; const int pw = isA ? 2 * f : f;
            for (int i = 0; i < pw; ++i) inv *= c16;
            const double ang = (double)pos * inv; const double twopi = 6.283185307179586476925;
            const double x = ang - twopi * __builtin_rint(ang / twopi);
            const double x2 = x * x; double sn = 0.0, cs = 0.0, ts = x, tc = 1.0;
            for (int k = 0; k < 14; ++k) { sn += ts; cs += tc; tc = -tc * x2 / (double)((2 * k + 1) * (2 * k + 2)); ts = -ts * x2 / (double)((2 * k + 2) * (2 * k + 3)); }
            f32x2* T = isA ? (f32x2*)(ws + WS_ROPE_A) + pos * 8 + f : (f32x2*)(ws + WS_ROPE_C) + pos * 16 + f;
            *T = (f32x2){(float)cs, (float)sn};
        }
    }
}

DI void p0b_phase() {
    FRESH_IDS
    unsigned char* ws = WSP(); asm volatile("" : "+s"(ws));
    const float* MOD = (const float*)(ws + WS_MOD);
    const int G = gridDim.x, NGW = G * 8, gw = blockIdx.x * 8 + wave;
    {
        float* GM = (float*)(ws + WS_GM);
        for (int i = blockIdx.x * GSZ + tid; i < 7 * 5 * 1024; i += G * GSZ) {
            const int e = i & 1023, cond = (i >> 10) % 5, k = i / 5120, l = k / 3, w3 = k % 3;
            if (k == 6) { GM[i] = INP(31)[e]; continue; }
            const float* g = (w3 == 0 ? INP(8) : (w3 == 1 ? INP(11) : INP(12))) + l * DM;
            GM[i] = g[e] * (1.f + MOD[(size_t)(l * 5 + cond) * NMOD + (3 * w3 + 1) * 1024 + e]);
        }
    }
    bias_rows(0, lane, gw, NGW); bias_rows(1, lane, gw, NGW);
    {
        bf16_t* HB = (bf16_t*)(ws + WS_HB); float* SS0 = (float*)(ws + WS_SS);
        const float* g = INP(8);
        for (int rb = gw; rb < NTOK / 8; rb += NGW) {
            const int cond = rb < 1024 ? 4 : ((rb - 1024) >> 8);
            const float* mp = MOD + (size_t)cond * NMOD;
            const float* xs = rb < 1024 ? INP(0) : INP(1) - (size_t)NPR * DM;
            f32x4 gm[4];
#pragma unroll
            for (int j = 0; j < 4; ++j) { const int e = 4 * lane + 256 * j; const f32x4 gv = *(const f32x4*)(g + e), sc = *(const f32x4*)(mp + 1024 + e); gm[j] = gv * (sc + 1.0f); }
            for (int r = 0; r < 8; ++r) {
                const size_t row = (size_t)rb * 8 + r;
                const f32x4* xr = (const f32x4*)(xs + row * DM) + lane;
                f32x4 v[4]; float ssq = 0.f;
#pragma unroll
                for (int j = 0; j < 4; ++j) { v[j] = xr[64 * j]; ssq += (v[j].x * v[j].x + v[j].y * v[j].y) + (v[j].z * v[j].z + v[j].w * v[j].w); }
                ssq = wave_sum(ssq);
                if (lane == 0) *(f32x4*)(SS0 + row * 4) = (f32x4){ssq, 0.f, 0.f, 0.f};
                u32x2* o = (u32x2*)(HB + row * DM) + lane;
#pragma unroll
                for (int j = 0; j < 4; ++j) { const f32x4 y = v[j] * gm[j]; u32x2 w; w.x = pk2(y.x, y.y); w.y = pk2(y.z, y.w); o[64 * j] = w; }
            }
        }
    }
}
DI void final_phase() {
    FRESH_IDS
    unsigned char* ws = WSP(); asm volatile("" : "+s"(ws));
    const bf16_t* XG = (const bf16_t*)(ws + WS_HB); const float* SS6 = (const float*)(ws + WS_SS) + (size_t)6 * NTOK * 4;
    float* out = OUTP();
    const int NGW = gridDim.x * 8;
    for (int row = blockIdx.x * 8 + wave; row < NTOK; row += NGW) {
        const f32x4 sp4 = *(const f32x4*)(SS6 + (size_t)row * 4);
        const float rstd = rsqrtf(((sp4.x + sp4.y) + (sp4.z + sp4.w)) * (1.f / DM) + EPS);
        const u32x2* xr = (const u32x2*)(XG + (size_t)row * DM) + lane;
        f32x4* orow = (f32x4*)(out + (size_t)row * DM) + lane;
        u32x2 v[4];
#pragma unroll
        for (int j = 0; j < 4; ++j) v[j] = xr[64 * j];
#pragma unroll
        for (int j = 0; j < 4; ++j) orow[64 * j] = (f32x4){bflo(v[j].x), bfhi(v[j].x), bflo(v[j].y), bfhi(v[j].y)} * rstd;
    }
}

DI void e1_phase(char* lds) {
    FRESH_IDS
    unsigned char* ws = WSP(); asm volatile("" : "+s"(ws));
    const bf16_t* RAW = (const bf16_t*)(ws + WS_RAW);
    bf16_t* CQN = (bf16_t*)(ws + WS_CQN); bf16_t* CKVN = (bf16_t*)(ws + WS_CKVN); bf16_t* KR = (bf16_t*)(ws + WS_KR);
    bf16_t* MIX = (bf16_t*)(ws + WS_MIX0);
    const f32x2* ropeA = (const f32x2*)(ws + WS_ROPE_A);
    const int G = gridDim.x, NGW = G * 8;
    {
        const float* gq = INP(18); const float* gkv = INP(20);
        float gql[6]; f32x4 gk4;
#pragma unroll
        for (int j = 0; j < 3; ++j) { gql[2 * j] = gq[2 * lane + 128 * j]; gql[2 * j + 1] = gq[2 * lane + 128 * j + 1]; }
        gk4 = *(const f32x4*)(gkv + 4 * lane);
        float* outp = OUTP();
        int t = blockIdx.x * 8 + wave;
        unsigned cw[3]; u32x2 kw; unsigned short krw;
        if (t < NTOK) { const bf16_t* rr = RAW + (size_t)t * INA_P;
#pragma unroll
            for (int j = 0; j < 3; ++j) cw[j] = *(const unsigned*)(rr + 2 * lane + 128 * j);
            kw = *(const u32x2*)(rr + 384 + 4 * lane); krw = rr[640 + (lane & 31)]; }
        for (; t < NTOK; t += NGW) {
            unsigned cwn[3]; u32x2 kwn; unsigned short krn; const int tn = t + NGW;
            if (tn < NTOK) { const bf16_t* rn = RAW + (size_t)tn * INA_P;
#pragma unroll
                for (int j = 0; j < 3; ++j) cwn[j] = *(const unsigned*)(rn + 2 * lane + 128 * j);
                kwn = *(const u32x2*)(rn + 384 + 4 * lane); krn = rn[640 + (lane & 31)]; }
            float ss = 0.f;
#pragma unroll
            for (int j = 0; j < 3; ++j) { const float x0 = bflo(cw[j]), x1 = bfhi(cw[j]); ss += x0 * x0 + x1 * x1; }
            f32x4 kv = (f32x4){bflo(kw.x), bfhi(kw.x), bflo(kw.y), bfhi(kw.y)};
            float sk = (kv.x * kv.x + kv.y * kv.y) + (kv.z * kv.z + kv.w * kv.w);
#pragma unroll
            for (int o = 1; o < 64; o <<= 1) { ss += __shfl_xor(ss, o); sk += __shfl_xor(sk, o); }
            const float rq = rsqrtf(ss * (1.f / 384.f) + EPS);
#pragma unroll
            for (int j = 0; j < 3; ++j) *(unsigned*)(CQN + (size_t)t * 384 + 2 * lane + 128 * j) = pk2(bflo(cw[j]) * rq * gql[2 * j], bfhi(cw[j]) * rq * gql[2 * j + 1]);
            const float rk = rsqrtf(sk * (1.f / 256.f) + EPS);
            kv = kv * rk * gk4;
            if (t < NPR) *(f32x4*)(outp + OUT_CKV + (size_t)t * 256 + 4 * lane) = kv;
            { u32x2 w; w.x = pk2(kv.x, kv.y); w.y = pk2(kv.z, kv.w); *(u32x2*)(CKVN + (size_t)t * 256 + 4 * lane) = w; }
            {
                const float v = bf2f(krw);
                if (t < NPR) {
                    if (lane < 32) { outp[OUT_KROPE + (size_t)t * 32 + lane] = v; KR[(size_t)t * 32 + lane] = krw; }
                } else {
                    const int uu = t - NPR, b = uu >> 11, p = uu & 2047; const int j = lane & 31; const int pos = (j < 16) ? (p >> 6) : (p & 63);
                    const float o = __shfl_xor(v, 8); const f32x2 cs = ropeA[pos * 8 + (j & 7)];
                    const float y = (j & 8) ? (v * cs.x + o * cs.y) : (v * cs.x - o * cs.y);
                    if (lane < 32) KR[(size_t)NPR * 32 + ((size_t)b * 2560 + 512 + p) * 32 + lane] = (bf16_t)(pk2(y, 0.f) & 0xffff);
                }
            }
#pragma unroll
            for (int j = 0; j < 3; ++j) cw[j] = cwn[j];
            kw = kwn; krw = krn;
        }
    }
    {
        bf16_t* gls = (bf16_t*)lds;
        float* cv = (float*)(lds + 63488);
        const int c = tid;
        float w[31];
#pragma unroll
        for (int j = 0; j < 31; ++j) w[j] = INP(22)[j * 512 + c];
        const float bdw = INP(23)[c];
        float gln[8], bln[8];
#pragma unroll
        for (int i = 0; i < 8; ++i) { gln[i] = INP(24)[lane * 8 + i]; bln[i] = INP(25)[lane * 8 + i]; }
        for (int tile = blockIdx.x; tile < NTOK / 32; tile += G) {
            const int t0 = tile * 32;
            int s0, s1;
            if (t0 < NPR) { s0 = t0 & ~255; s1 = s0 + 256; } else { s0 = NPR + ((t0 - NPR) & ~2047); s1 = s0 + 2048; }
            u32x4 av[8], bv[8];
#pragma unroll
            for (int k = 0; k < 8; ++k) { const int i = wave + 8 * k; int tt = t0 - 15 + i; tt = tt < s0 ? s0 : (tt >= s1 ? s1 - 1 : tt);
                const bf16_t* rr = RAW + (size_t)tt * INA_P + 672 + lane * 8; av[k] = *(const u32x4*)rr; bv[k] = *(const u32x4*)(rr + 512); }
#pragma unroll
            for (int k = 0; k < 8; ++k) { const int i = wave + 8 * k; const int tt = t0 - 15 + i; const bool valid = (tt >= s0) && (tt < s1);
                u32x4 o;
#pragma unroll
                for (int e = 0; e < 4; ++e) { const float g0 = bflo(av[k][e]) * sigmoid_f(bflo(bv[k][e])), g1 = bfhi(av[k][e]) * sigmoid_f(bfhi(bv[k][e])); o[e] = valid ? pk2(g0, g1) : 0u; }
                if (i < 62) *(u32x4*)(gls + i * 512 + lane * 8) = o; }
            __syncthreads();
            float acc[32];
#pragma unroll
            for (int o = 0; o < 32; ++o) acc[o] = bdw;
#pragma unroll
            for (int i = 0; i < 62; ++i) {
                const float gl = bf2f(gls[i * 512 + c]);
#pragma unroll
                for (int o = 0; o < 32; ++o) { const int j = i - o; if (j >= 0 && j < 31) acc[o] += w[j] * gl; }
            }
#pragma unroll
            for (int o = 0; o < 32; ++o) cv[o * 512 + c] = acc[o];
            __syncthreads();
#pragma unroll
            for (int q = 0; q < 4; ++q) {
                const int o = wave * 4 + q;
                float v[8]; float sm = 0.f;
                { const f32x4 c0 = *(const f32x4*)(cv + o * 512 + lane * 8), c1 = *(const f32x4*)(cv + o * 512 + lane * 8 + 4);
                  v[0] = c0.x; v[1] = c0.y; v[2] = c0.z; v[3] = c0.w; v[4] = c1.x; v[5] = c1.y; v[6] = c1.z; v[7] = c1.w; }
#pragma unroll
                for (int i = 0; i < 8; ++i) sm += v[i];
                const float mu = wave_sum(sm) * (1.f / 512.f); float s2 = 0.f;
#pragma unroll
                for (int i = 0; i < 8; ++i) { v[i] -= mu; s2 += v[i] * v[i]; }
                const float rstd = rsqrtf(wave_sum(s2) * (1.f / 512.f) + EPS);
                float y[8];
#pragma unroll
                for (int i = 0; i < 8; ++i) y[i] = silu_f(v[i] * rstd * gln[i] + bln[i]);
                u32x4 w; w.x = pk2(y[0], y[1]); w.y = pk2(y[2], y[3]); w.z = pk2(y[4], y[5]); w.w = pk2(y[6], y[7]);
                *(u32x4*)(MIX + (size_t)(t0 + o) * DM + 512 + lane * 8) = w;
            }
        }
        __syncthreads();
    }
}

DI void e2_phase() {
    FRESH_IDS
    unsigned char* ws = WSP(); asm volatile("" : "+s"(ws));
    const bf16_t* RAW = (const bf16_t*)(ws + WS_RAW);
    bf16_t* QB = (bf16_t*)(ws + WS_QB1); bf16_t* KB = (bf16_t*)(ws + WS_KB1); bf16_t* VB = (bf16_t*)(ws + WS_VT1);
    const f32x2* ropeC = (const f32x2*)(ws + WS_ROPE_C);
    float* out = OUTP();
    const int NGW = gridDim.x * 8;
    const int sub = lane & 7, hsel = lane >> 3;
    float gq[8], gk[8];
#pragma unroll
    for (int i = 0; i < 8; ++i) { gq[i] = INP(28)[sub * 8 + i]; gk[i] = INP(29)[sub * 8 + i]; }
    const float qs = 0.125f * LOG2E;
    int t = blockIdx.x * 8 + wave;
    u32x4 w[3];
    if (t < NTOK) {
#pragma unroll
        for (int j = 0; j < 3; ++j) w[j] = *(const u32x4*)(RAW + (size_t)t * INC + j * 512 + lane * 8);
    }
    for (; t < NTOK; t += NGW) {
        u32x4 wn[3];
        const int tn = t + NGW;
        if (tn < NTOK) {
#pragma unroll
            for (int j = 0; j < 3; ++j) wn[j] = *(const u32x4*)(RAW + (size_t)tn * INC + j * 512 + lane * 8);
        }
        const bool lat = t >= NPR;
        int p = 0, key, Sk; unsigned kbase;
        if (!lat) { const int sq = t >> 8; key = t & 255; Sk = 256; kbase = (unsigned)sq * 4u * 256u; }
        else { const int uu = t - NPR, b = uu >> 11; p = uu & 2047; key = 512 + p; Sk = 2560; kbase = 32u * 4u * 256u + (unsigned)b * 4u * 2560u; }
        f32x2 cs[8];
        if (lat) { const int pos = (sub & 4) ? (p & 63) : (p >> 6); const f32x2* rp = ropeC + pos * 16 + (sub & 1) * 8;
#pragma unroll
            for (int i = 0; i < 8; ++i) cs[i] = rp[i]; }
        else {
#pragma unroll
            for (int i = 0; i < 8; ++i) cs[i] = (f32x2){1.f, 0.f}; }
#pragma unroll
        for (int j = 0; j < 3; ++j) {
            float v[8];
#pragma unroll
            for (int i = 0; i < 4; ++i) { v[2 * i] = bflo(w[j][i]); v[2 * i + 1] = bfhi(w[j][i]); }
            const bool isv = (j == 2) && (hsel >= 4);
            const bool isk = (j == 2) && (hsel < 4);
            float ss = 0.f;
#pragma unroll
            for (int i = 0; i < 8; ++i) ss += v[i] * v[i];
            ss += __shfl_xor(ss, 1); ss += __shfl_xor(ss, 2); ss += __shfl_xor(ss, 4);
            const float rs = rsqrtf(ss * (1.f / 64.f) + EPS);
            float nv[8], y[8];
#pragma unroll
            for (int i = 0; i < 8; ++i) nv[i] = v[i] * rs * (j == 2 ? gk[i] : gq[i]);
#pragma unroll
            for (int i = 0; i < 8; ++i) { const float o = __shfl_xor(nv[i], 2); y[i] = (sub & 2) ? (nv[i] * cs[i].x + o * cs[i].y) : (nv[i] * cs[i].x - o * cs[i].y); }
            if (j < 2) {
                u32x4 o4; o4.x = pk2(y[0] * qs, y[1] * qs); o4.y = pk2(y[2] * qs, y[3] * qs); o4.z = pk2(y[4] * qs, y[5] * qs); o4.w = pk2(y[6] * qs, y[7] * qs);
                *(u32x4*)(QB + (size_t)t * DM + (8 * j + hsel) * 64 + sub * 8) = o4;
            } else if (isk) {
                const int kvh = hsel;
                u32x4 o4; o4.x = pk2(y[0], y[1]); o4.y = pk2(y[2], y[3]); o4.z = pk2(y[4], y[5]); o4.w = pk2(y[6], y[7]);
                *(u32x4*)(KB + (size_t)(kbase + (unsigned)kvh * Sk + key) * 64 + sub * 8) = o4;
                if (!lat) { float* op = out + OUT_GK + (size_t)t * 256 + kvh * 64 + sub * 8; *(f32x4*)op = (f32x4){nv[0], nv[1], nv[2], nv[3]}; *(f32x4*)(op + 4) = (f32x4){nv[4], nv[5], nv[6], nv[7]}; }
            } else if (isv) {
                const int kvh = hsel - 4;
                *(u32x4*)(VB + (size_t)(kbase + (unsigned)kvh * Sk + key) * 64 + sub * 8) = w[2];
                if (!lat) { float* op = out + OUT_GV + (size_t)t * 256 + kvh * 64 + sub * 8; *(f32x4*)op = (f32x4){v[0], v[1], v[2], v[3]}; *(f32x4*)(op + 4) = (f32x4){v[4], v[5], v[6], v[7]}; }
            }
        }
#pragma unroll
        for (int j = 0; j < 3; ++j) w[j] = wn[j];
    }
}

#define GAS1 __attribute__((address_space(1)))
template <int DK>
DI void attn_unit(char* lds, const bf16_t* Qp, int qpitch, const bf16_t* Kh, const bf16_t* KRs, const bf16_t* VTh, int Sk, bf16_t* Op, int tid, int lane, int wave, const f32x2* ropeA, int pos0) {
    constexpr int DKP = DK + 8, KROW = DKP * 2, KT_B = 128 * KROW, VT_B = 128 * 144, BUF_B = KT_B + VT_B, NS = DK / 16;
    const int q = lane & 31, hi = lane >> 5;
    bf16x8 qf[NS];
#pragma unroll
    for (int s = 0; s < NS; ++s) qf[s] = *(const GAS1 bf16x8*)(Qp + (size_t)(wave * 32 + q) * qpitch + s * 16 + hi * 8);
    if (DK == 96) { if (ropeA) {
        const int p = pos0 + wave * 32 + q;
#pragma unroll
        for (int s = 4; s < 6; ++s) {
            const int pos = (s == 4) ? (p >> 6) : (p & 63);
            const u32x4 w = __builtin_bit_cast(u32x4, qf[s < NS ? s : 0]); u32x4 r;
#pragma unroll
            for (int j = 0; j < 4; ++j) {
                const unsigned wj = w[j]; const float x0 = bflo(wj), x1 = bfhi(wj);
                const float y0 = __shfl_xor(x0, 32), y1 = __shfl_xor(x1, 32);
                const f32x2 c0 = ((const GAS1 f32x2*)ropeA)[pos * 8 + 2 * j], c1 = ((const GAS1 f32x2*)ropeA)[pos * 8 + 2 * j + 1];
                const float z0 = hi ? (x0 * c0.x + y0 * c0.y) : (x0 * c0.x - y0 * c0.y);
                const float z1 = hi ? (x1 * c1.x + y1 * c1.y) : (x1 * c1.x - y1 * c1.y);
                r[j] = cvtpk_s(z0, z1);
            }
            qf[s < NS ? s : 0] = __builtin_bit_cast(bf16x8, r);
        }
    } }
    f32x16 o0, o1;
#pragma unroll
    for (int r = 0; r < 16; ++r) { o0[r] = 0.f; o1[r] = 0.f; }
    float mrun = -1e30f, lsum = 0.f;
    const int NT = Sk / 128;
    const int kkey = tid >> 3, kch = tid & 7;
    const int rkey = tid >> 2, rch = tid & 3;
    u32x4 gk0, gk1, gr, gv0, gv1;
    gk0 = *(const GAS1 u32x4*)(Kh + (size_t)kkey * 64 + kch * 8); gk1 = *(const GAS1 u32x4*)(Kh + (size_t)(64 + kkey) * 64 + kch * 8);
    if (DK == 96) gr = *(const GAS1 u32x4*)(KRs + (size_t)rkey * 32 + rch * 8);
    gv0 = *(const GAS1 u32x4*)(VTh + (size_t)kkey * 64 + kch * 8); gv1 = *(const GAS1 u32x4*)(VTh + (size_t)(64 + kkey) * 64 + kch * 8);
    __syncthreads();
    {
        char* kb = lds; char* vb = lds + KT_B;
        *(u32x4*)(kb + kkey * KROW + kch * 16) = gk0; *(u32x4*)(kb + (64 + kkey) * KROW + kch * 16) = gk1;
        if (DK == 96) *(u32x4*)(kb + rkey * KROW + 128 + rch * 16) = gr;
        *(u32x4*)(vb + kkey * 144 + kch * 16) = gv0; *(u32x4*)(vb + (64 + kkey) * 144 + kch * 16) = gv1;
    }
    __syncthreads();
    for (int t = 0; t < NT; ++t) {
        const char* kb = lds + (t & 1) * BUF_B; const char* vb = kb + KT_B;
        if (t + 1 < NT) {
            const int k0 = (t + 1) * 128;
            gk0 = *(const GAS1 u32x4*)(Kh + (size_t)(k0 + kkey) * 64 + kch * 8); gk1 = *(const GAS1 u32x4*)(Kh + (size_t)(k0 + 64 + kkey) * 64 + kch * 8);
            if (DK == 96) gr = *(const GAS1 u32x4*)(KRs + (size_t)(k0 + rkey) * 32 + rch * 8);
            gv0 = *(const GAS1 u32x4*)(VTh + (size_t)(k0 + kkey) * 64 + kch * 8); gv1 = *(const GAS1 u32x4*)(VTh + (size_t)(k0 + 64 + kkey) * 64 + kch * 8);
        }
        f32x16 p[4];
#pragma unroll
        for (int b = 0; b < 4; ++b)
#pragma unroll
            for (int r = 0; r < 16; ++r) p[b][r] = 0.f;
#pragma unroll
        for (int s = 0; s < NS; ++s)
#pragma unroll
            for (int b = 0; b < 4; ++b) {
                const bf16x8 kf = *(const bf16x8*)(kb + (32 * b + q) * KROW + s * 32 + hi * 16);
                p[b] = __builtin_amdgcn_mfma_f32_32x32x16_bf16(kf, qf[s], p[b], 0, 0, 0);
            }
        float mx4[4];
#pragma unroll
        for (int b = 0; b < 4; ++b) { float m = __builtin_fmaxf(__builtin_fmaxf(p[b][0], p[b][1]), p[b][2]);
#pragma unroll
            for (int r = 3; r < 15; r += 2) m = __builtin_fmaxf(__builtin_fmaxf(m, p[b][r]), p[b][r + 1]);
            mx4[b] = __builtin_fmaxf(m, p[b][15]); }
        float mx = __builtin_fmaxf(__builtin_fmaxf(mx4[0], mx4[1]), __builtin_fmaxf(mx4[2], mx4[3]));
        mx = __builtin_fmaxf(mx, __shfl_xor(mx, 32));
        const float mnew = __builtin_fmaxf(mrun, mx);
        float ps4[4];
#pragma unroll
        for (int b = 0; b < 4; ++b) { float a = 0.f;
#pragma unroll
            for (int r = 0; r < 16; ++r) { p[b][r] = __builtin_amdgcn_exp2f(p[b][r] - mnew); a += p[b][r]; }
            ps4[b] = a; }
        if (__any(mnew != mrun)) {
            const float alpha = __builtin_amdgcn_exp2f(mrun - mnew);
            lsum *= alpha;
#pragma unroll
            for (int r = 0; r < 16; ++r) { o0[r] *= alpha; o1[r] *= alpha; }
        }
        mrun = mnew;
        lsum += (ps4[0] + ps4[1]) + (ps4[2] + ps4[3]);
#pragma unroll
        for (int b = 0; b < 4; ++b)
#pragma unroll
            for (int s = 0; s < 2; ++s) {
                u32x4 pw;
                pw.x = cvtpk_s(p[b][8 * s], p[b][8 * s + 1]); pw.y = cvtpk_s(p[b][8 * s + 2], p[b][8 * s + 3]); pw.z = cvtpk_s(p[b][8 * s + 4], p[b][8 * s + 5]); pw.w = cvtpk_s(p[b][8 * s + 6], p[b][8 * s + 7]);
                const bf16x8 pf = __builtin_bit_cast(bf16x8, pw);
                const int krow0 = 32 * b + 16 * s + 4 * hi + ((lane & 15) >> 2);
                const int cofs = (16 * ((lane >> 4) & 1) + 4 * (lane & 3)) * 2;
                typedef short v4i16_t __attribute__((ext_vector_type(4)));
                typedef __attribute__((address_space(3))) v4i16_t* ldsv4;
                const s16x4 a0 = __builtin_amdgcn_ds_read_tr16_b64_v4i16((ldsv4)(vb + krow0 * 144 + cofs));
                const s16x4 a1 = __builtin_amdgcn_ds_read_tr16_b64_v4i16((ldsv4)(vb + (krow0 + 8) * 144 + cofs));
                const s16x4 b0 = __builtin_amdgcn_ds_read_tr16_b64_v4i16((ldsv4)(vb + krow0 * 144 + 64 + cofs));
                const s16x4 b1 = __builtin_amdgcn_ds_read_tr16_b64_v4i16((ldsv4)(vb + (krow0 + 8) * 144 + 64 + cofs));
                const bf16x8 v0f = __builtin_shufflevector(a0, a1, 0, 1, 2, 3, 4, 5, 6, 7);
                const bf16x8 v1f = __builtin_shufflevector(b0, b1, 0, 1, 2, 3, 4, 5, 6, 7);
                o0 = __builtin_amdgcn_mfma_f32_32x32x16_bf16(v0f, pf, o0, 0, 0, 0);
                o1 = __builtin_amdgcn_mfma_f32_32x32x16_bf16(v1f, pf, o1, 0, 0, 0);
            }
        if (t + 1 < NT) {
            char* kn = lds + ((t + 1) & 1) * BUF_B; char* vn = kn + KT_B;
            *(u32x4*)(kn + kkey * KROW + kch * 16) = gk0; *(u32x4*)(kn + (64 + kkey) * KROW + kch * 16) = gk1;
            if (DK == 96) *(u32x4*)(kn + rkey * KROW + 128 + rch * 16) = gr;
            *(u32x4*)(vn + kkey * 144 + kch * 16) = gv0; *(u32x4*)(vn + (64 + kkey) * 144 + kch * 16) = gv1;
        }
        __syncthreads();
    }
    const float ltot = lsum + __shfl_xor(lsum, 32);
    const float inv = 1.0f / ltot;
    {
        char* stg = lds + wave * 4608;
#pragma unroll
        for (int g4 = 0; g4 < 4; ++g4) {
            const int dv = 8 * g4 + 4 * hi;
            u32x2 w0, w1;
            w0.x = pk2(o0[4 * g4] * inv, o0[4 * g4 + 1] * inv); w0.y = pk2(o0[4 * g4 + 2] * inv, o0[4 * g4 + 3] * inv);
            w1.x = pk2(o1[4 * g4] * inv, o1[4 * g4 + 1] * inv); w1.y = pk2(o1[4 * g4 + 2] * inv, o1[4 * g4 + 3] * inv);
            *(u32x2*)(stg + q * 144 + dv * 2) = w0; *(u32x2*)(stg + q * 144 + 64 + dv * 2) = w1;
        }
        asm volatile("s_waitcnt lgkmcnt(0)" ::: "memory");
#pragma unroll
        for (int i = 0; i < 4; ++i) {
            const int row = i * 8 + (lane >> 3), ch = lane & 7;
            const u32x4 v = *(const u32x4*)(stg + row * 144 + ch * 16);
            *(u32x4*)(Op + (size_t)(wave * 32 + row) * DM + ch * 8) = v;
        }
    }
}

DI void attn_mla_phase(char* lds) {
    FRESH_IDS
    unsigned char* ws = WSP(); asm volatile("" : "+s"(ws));
    const bf16_t* QB = (const bf16_t*)(ws + WS_QB0); const bf16_t* KB = (const bf16_t*)(ws + WS_KB0); const bf16_t* VT = (const bf16_t*)(ws + WS_VT0); const bf16_t* KR = (const bf16_t*)(ws + WS_KR);
    bf16_t* MIX = (bf16_t*)(ws + WS_MIX0);
    const int G = gridDim.x; const int bx = blockIdx.x;
    const int vb = (G % 8 == 0) ? (bx % 8) * (G / 8) + bx / 8 : bx;
    for (int u = vb; u < 512; u += G) {
        int tok0, h, Sk, pos0; unsigned kofs, rofs; const f32x2* rp;
        if (u < 256) { const int qb = u & 7, b = u >> 6; h = (u >> 3) & 7; tok0 = NPR + b * 2048 + qb * 256; Sk = 2560; pos0 = qb * 256; rp = (const f32x2*)(ws + WS_ROPE_A);
            kofs = (32u * 8u * 256u + (unsigned)(b * 8 + h) * 2560u) * 64u; rofs = (unsigned)NPR * 32u + (unsigned)b * 2560u * 32u; }
        else { const int v = u - 256; h = v & 7; const int sq = v >> 3; tok0 = sq * 256; Sk = 256; pos0 = 0; rp = nullptr;
            kofs = (unsigned)(sq * 8 + h) * 256u * 64u; rofs = (unsigned)sq * 256u * 32u; }
        attn_unit<96>(lds, QB + (size_t)tok0 * 768 + h * 96, 768, KB + kofs, KR + rofs, VT + kofs, Sk, MIX + (size_t)tok0 * DM + h * 64, tid, lane, wave, rp, pos0);
    }
    __syncthreads();
}
DI void attn_gqa_phase(char* lds) {
    FRESH_IDS
    unsigned char* ws = WSP(); asm volatile("" : "+s"(ws));
    const bf16_t* QB = (const bf16_t*)(ws + WS_QB1); const bf16_t* KB = (const bf16_t*)(ws + WS_KB1); const bf16_t* VT = (const bf16_t*)(ws + WS_VT1);
    bf16_t* MIX = (bf16_t*)(ws + WS_MIX1);
    const int G = gridDim.x; const int bx = blockIdx.x;
    const int vb = (G % 8 == 0) ? (bx % 8) * (G / 8) + bx / 8 : bx;
    for (int u = vb; u < 1024; u += G) {
        int tok0, h, Sk; unsigned kofs;
        if (u < 512) { const int qb = u & 7, b = u >> 7; h = (u >> 3) & 15; const int kvh = h >> 2; tok0 = NPR + b * 2048 + qb * 256; Sk = 2560;
            kofs = (32u * 4u * 256u + (unsigned)(b * 4 + kvh) * 2560u) * 64u; }
        else { const int v = u - 512; h = v & 15; const int sq = v >> 4, kvh = h >> 2; tok0 = sq * 256; Sk = 256;
            kofs = (unsigned)(sq * 4 + kvh) * 256u * 64u; }
        attn_unit<64>(lds, QB + (size_t)tok0 * DM + h * 64, DM, KB + kofs, nullptr, VT + kofs, Sk, MIX + (size_t)tok0 * DM + h * 64, tid, lane, wave, nullptr, 0);
    }
    __syncthreads();
}


#define LAS __attribute__((address_space(3)))
#define XB_TMO      128
#define XB_XCNT(j)  (256  + 64 * (j))
#define XB_XSUB(j)  (1280 + 64 * (j))
#define XB_XGEN(j)  (2304 + 64 * (j))
#define XB_TOP      3328
#define XB_TOPGEN   3392
#define XCD_BAR_WORDS 3456
#define XB_SPIN_CAP (1u << 18)
__device__ __forceinline__ unsigned xb_ld(unsigned* p)              { return __hip_atomic_load(p, __ATOMIC_RELAXED, __HIP_MEMORY_SCOPE_AGENT); }
__device__ __forceinline__ unsigned xb_add(unsigned* p, unsigned v) { return __hip_atomic_fetch_add(p, v, __ATOMIC_RELAXED, __HIP_MEMORY_SCOPE_AGENT); }
__device__ __forceinline__ unsigned xb_xcc_id() { return (unsigned)__builtin_amdgcn_s_getreg((3 << 11) | 20) & 0xFu; }
#define XB_SPIN(cond, bar) do { unsigned _sp = 0; while (cond) { __builtin_amdgcn_s_sleep(1); \
    if ((++_sp & 255u) == 0u) { if (xb_ld(&(bar)[XB_TMO])) break; if (_sp > XB_SPIN_CAP) { atomicAdd(&(bar)[XB_TMO], 1u); break; } } } } while (0)
struct XcdBarrier { unsigned* bar; unsigned x; volatile LAS unsigned* st; };
__device__ __forceinline__ XcdBarrier xcd_barrier_post(unsigned* bar, volatile LAS unsigned* st) {
    XcdBarrier b; b.bar = bar; b.x = xb_xcc_id(); b.st = st;
    if (threadIdx.x == 0) (void)xb_add(&bar[XB_XCNT(b.x)], 1u);
    return b;
}
__device__ __forceinline__ void xcd_barrier_complete(unsigned* bar, unsigned x, unsigned& nloc, unsigned& nx) {
    const unsigned G = gridDim.x * gridDim.y * gridDim.z;
    unsigned sum, cnt, mine, sp = 0u;
    for (;;) {
        sum = 0u; cnt = 0u; mine = 0u;
#pragma unroll
        for (unsigned j = 0; j < 16; ++j) { const unsigned c = xb_ld(&bar[XB_XCNT(j)]); sum += c; cnt += (c > 0u) ? 1u : 0u; mine = (j == x) ? c : mine; }
        if (sum == G) break;
        __builtin_amdgcn_s_sleep(1);
        if ((++sp & 255u) == 0u) { if (xb_ld(&bar[XB_TMO])) break; if (sp > XB_SPIN_CAP) { atomicAdd(&bar[XB_TMO], 1u); break; } }
    }
    nloc = mine > 0u ? mine : 1u; nx = cnt > 0u ? cnt : 1u;
}
__device__ __forceinline__ void xcd_barrier(unsigned* bar, volatile LAS unsigned* st) {
    asm volatile("s_waitcnt vmcnt(0)" ::: "memory");
    __syncthreads();
    if (threadIdx.x == 0) {
        const unsigned x = xb_xcc_id();
        __builtin_amdgcn_s_waitcnt(0);
        unsigned nloc = st[0], nx = st[1];
        if (nloc == 0u) { xcd_barrier_complete(bar, x, nloc, nx); st[0] = nloc; st[1] = nx; }
        const unsigned old = xb_add(&bar[XB_XSUB(x)], 1u);
        const unsigned gen = old / nloc;
        if (old + 1u == (gen + 1u) * nloc) {
            __builtin_amdgcn_fence(__ATOMIC_RELEASE, "agent");
            asm volatile("s_waitcnt vmcnt(0)" ::: "memory");
            const unsigned og = xb_add(&bar[XB_TOP], 1u);
            const unsigned tg = og / nx;
            if (og + 1u == (tg + 1u) * nx) xb_add(&bar[XB_TOPGEN], 1u);
            else XB_SPIN(xb_ld(&bar[XB_TOPGEN]) == tg, bar);
            __builtin_amdgcn_fence(__ATOMIC_ACQUIRE, "agent");
            xb_add(&bar[XB_XGEN(x)], 1u);
            asm volatile("s_waitcnt vmcnt(0)" ::: "memory");
        } else {
            XB_SPIN(xb_ld(&bar[XB_XGEN(x)]) == gen, bar);
            __builtin_amdgcn_fence(__ATOMIC_ACQUIRE, "agent");
            asm volatile("s_waitcnt vmcnt(0)" ::: "memory");
        }
    }
    __syncthreads();
}

#define WSF() ({ unsigned char* w_ = WSP(); asm volatile("" : "+s"(w_)); w_; })
#define LND_S(p) asm volatile("" : "+s"(p))
__global__ void __launch_bounds__(512, 2) fwd_kernel(Args a) {
    extern __shared__ __attribute__((aligned(16))) unsigned char lds_raw[];
    cg::grid_group grid = cg::this_grid();
    PG8_LAS unsigned char* ldsg = (PG8_LAS unsigned char*)lds_raw;
    char* lds = (char*)lds_raw;
    volatile LAS unsigned* bst = (volatile LAS unsigned*)(ldsg + 131072);
    if (threadIdx.x < 2) bst[threadIdx.x] = 0u;
    if (threadIdx.x < 68) ((LAS unsigned*)(ldsg + LDS_PTAB))[threadIdx.x] = ((const unsigned*)&a)[threadIdx.x];
    __syncthreads();
    (void)xcd_barrier_post((unsigned*)WSP(), bst);
#define GSYNC() do { unsigned* bw_ = (unsigned*)WSP(); asm volatile("" : "+s"(bw_)); xcd_barrier(bw_, bst); } while (0)

    phase0(lds);
    if (WSP() == nullptr) grid.sync();
    GSYNC();
    p0b_phase();
    GSYNC();

    for (int fb = 0; fb < 4; ++fb) {
        const int l = fb >> 1, wh = fb & 1;
        const int kff = 3 * l + 2 * wh;
        {
            unsigned char* ws = WSF(); int G = gridDim.x; LND_S(G);
            pg8::Gemm g{(const bf16_t*)(ws + WS_HB), (const bf16_t*)(ws + WS_WFFIN + fb * WFFIN_SZ), NTOK, 2 * FF, DM}; pg8::StaticOrder S; S.init(NTOK, 2 * FF, G, (int)blockIdx.x);
            EpiSwiglu E{(bf16_t*)(ws + WS_HID), (const float*)(ws + WS_SS) + (size_t)kff * NTOK * 4, (const float*)(ws + WS_BIAS) + (size_t)kff * 5 * 5632};
            pg8::gemm_phase<EpiSwiglu, pg8::StaticOrder, true, true>(ldsg, g, S, E);
            if (fb < 3) {
                const int nun = NTOK / 256 * (2 * FF / 256), nmax = (nun + G - 1) / G, nidle = G * nmax - nun; const int c = (int)blockIdx.x;
                FRESH_IDS
                if (nidle == 0) transpose_set(fb + 1, lds, c * 8 + wave, G * 8, lane, wave);
                else if (c >= G - nidle) transpose_set(fb + 1, lds, (c - (G - nidle)) * 8 + wave, nidle * 8, lane, wave);
            }
        }
        GSYNC();
        {
            unsigned char* ws = WSF(); int G = gridDim.x; LND_S(G); bf16_t* X = (bf16_t*)OUTP(); LND_S(X);
            const float* modl = (const float*)(ws + WS_MOD) + (size_t)l * 5 * NMOD;
            const float* xlo = INP(0);
            const float* xhi = INP(1) - (size_t)NPR * DM;
            if (fb == 1) { FRESH_IDS bias_rows(3, lane, (int)blockIdx.x * 8 + wave, G * 8); bias_rows(4, lane, (int)blockIdx.x * 8 + wave, G * 8); }
            pg8::Gemm g{(const bf16_t*)(ws + WS_HID), (const bf16_t*)(ws + WS_WFFOUT + fb * WFFOUT_SZ), NTOK, DM, FF}; pg8::StaticOrder S; S.init(NTOK, DM, G, (int)blockIdx.x);
            const int kn = kff + 1;
            EpiResid E{xlo, xhi, X, modl + (wh ? 8 : 2) * 1024, (bf16_t*)(ws + WS_HB), (const float*)(ws + WS_GM) + (size_t)kn * 5120, (float*)(ws + WS_SS) + (size_t)kn * NTOK * 4, 0.5f, 1, (kn == 6) ? 1 : 0, (fb != 0) ? 1 : 0};
            pg8::gemm_phase<EpiResid, pg8::StaticOrder, true, true>(ldsg, g, S, E);
        }
        GSYNC();
        if (wh == 0) {
            const int kmx = 3 * l + 1;
            {
                unsigned char* ws = WSF(); int G = gridDim.x; LND_S(G);
                const int N = l ? INC : INA_P;
                pg8::Gemm g{(const bf16_t*)(ws + WS_HB), (const bf16_t*)(ws + (l ? WS_WINC : WS_WINA)), NTOK, N, DM}; pg8::StaticOrder S; S.init(NTOK, N, G, (int)blockIdx.x);
                EpiStore<true> E{(bf16_t*)(ws + WS_RAW), N, 1.0f, (const float*)(ws + WS_SS) + (size_t)kmx * NTOK * 4, (const float*)(ws + WS_BIAS) + (size_t)kmx * 5 * 5632};
                pg8::gemm_phase<EpiStore<true>, pg8::StaticOrder, true, true>(ldsg, g, S, E);
                {
                    const int nun = NTOK / 256 * (N / 256), nmax = (nun + G - 1) / G, nidle = G * nmax - nun; const int c = (int)blockIdx.x;
                    FRESH_IDS
                    if (nidle == 0) bias_rows(3 * l + 2, lane, c * 8 + wave, G * 8);
                    else if (c >= G - nidle) bias_rows(3 * l + 2, lane, (c - (G - nidle)) * 8 + wave, nidle * 8);
                }
            }
            GSYNC();
            if (l == 0) {
                e1_phase(lds);
                GSYNC();
                {
                    unsigned char* ws = WSF(); int G = gridDim.x; LND_S(G);
                    pg8::Gemm g{(const bf16_t*)(ws + WS_CQN), (const bf16_t*)(ws + WS_WQUP), NTOK, 768, 384}; pg8::StaticOrder S; S.init(NTOK, 768, G, (int)blockIdx.x);
                    EpiStore<false> E{(bf16_t*)(ws + WS_QB0), 768, 0.10206207261596575f * LOG2E, nullptr, nullptr};
                    pg8::gemm_phase<EpiStore<false>, pg8::StaticOrder, true, true>(ldsg, g, S, E);
                }
                {
                    unsigned char* ws = WSF(); int G = gridDim.x; LND_S(G);
                    pg8::Gemm g{(const bf16_t*)(ws + WS_CKVN), (const bf16_t*)(ws + WS_WKVUP), 18432, 1024, 256}; pg8::StaticOrder S; S.init(18432, 1024, G, G - 1 - (int)blockIdx.x);
                    EpiKVup E{(bf16_t*)(ws + WS_KB0), (bf16_t*)(ws + WS_VT0)};
                    pg8::gemm_phase<EpiKVup, pg8::StaticOrder, true, true>(ldsg, g, S, E);
                }
                GSYNC();
                attn_mla_phase(lds);
            } else {
                e2_phase();
                GSYNC();
                attn_gqa_phase(lds);
            }
            GSYNC();
            {
                unsigned char* ws = WSF(); int G = gridDim.x; LND_S(G); bf16_t* X = (bf16_t*)OUTP(); LND_S(X);
                const float* modl = (const float*)(ws + WS_MOD) + (size_t)l * 5 * NMOD;
                pg8::Gemm g{(const bf16_t*)(ws + (l ? WS_MIX1 : WS_MIX0)), (const bf16_t*)(ws + (l ? WS_WOUTC : WS_WOUTA)), NTOK, DM, DM}; pg8::StaticOrder S; S.init(NTOK, DM, G, (int)blockIdx.x);
                const int kn = 3 * l + 2;
                EpiResid E{nullptr, nullptr, X, modl + 5 * 1024, (bf16_t*)(ws + WS_HB), (const float*)(ws + WS_GM) + (size_t)kn * 5120, (float*)(ws + WS_SS) + (size_t)kn * NTOK * 4, 1.0f, 1, 0, 1};
                pg8::gemm_phase<EpiResid, pg8::StaticOrder, true, true>(ldsg, g, S, E);
            }
            GSYNC();
        }
    }
    final_phase();
}

constexpr int LDS_BYTES = 136192;

extern "C" void kernel_launch(void* const* d_in, const int* in_sizes, int n_in, void* d_out, int out_size, void* d_ws, size_t ws_size, hipStream_t stream) {
    static int grid = 0;
    if (grid == 0) {
        if (n_in != 32 || ws_size < WS_END) { fprintf(stderr, "kernel_launch: unexpected n_in %d / ws %zu (need %zu)\n", n_in, ws_size, (size_t)WS_END); grid = -1; return; }
        int dev = 0, cus = 0, per_cu = 0;
        (void)hipGetDevice(&dev);
        (void)hipDeviceGetAttribute(&cus, hipDeviceAttributeMultiprocessorCount, dev);
        (void)hipFuncSetAttribute((const void*)fwd_kernel, hipFuncAttributeMaxDynamicSharedMemorySize, LDS_BYTES);
        if (hipOccupancyMaxActiveBlocksPerMultiprocessor(&per_cu, (const void*)fwd_kernel, 512, LDS_BYTES) != hipSuccess || per_cu < 1) per_cu = 1;
        (void)hipGetLastError();
        grid = cus * per_cu;
        if (grid > 256) grid = 256;
        if (grid < 1) grid = 256;
    }
    if (grid < 0) return;
    (void)hipMemsetAsync(d_ws, 0, WS_MOD + (size_t)2 * 5 * NMOD * 4, stream);
    Args a{};
    for (int i = 0; i < 32; ++i) a.in[i] = (const float*)d_in[i];
    a.out = (float*)d_out; a.ws = (unsigned char*)d_ws;
    void* args[] = {&a};
    hipError_t e = hipLaunchCooperativeKernel((const void*)fwd_kernel, dim3(grid), dim3(512), args, LDS_BYTES, stream);
    if (e != hipSuccess) fprintf(stderr, "cooperative launch failed: %s (grid %d)\n", hipGetErrorString(e), grid);
}
```

```cpp
#include <hip/hip_runtime.h>
#include <hip/hip_cooperative_groups.h>
#include <cstdio>
#include <cstdint>
namespace cg = cooperative_groups;

#define DI __device__ __forceinline__

namespace pg8 {
#define PG8_LAS __attribute__((address_space(3)))
typedef unsigned short bf16_t;
typedef short bf16x8 __attribute__((ext_vector_type(8)));
typedef float f32x4 __attribute__((ext_vector_type(4)));
typedef unsigned u32x4 __attribute__((ext_vector_type(4)));
constexpr int BM = 256, BK = 64, HALF = 128, HTB = HALF * BK * 2, STAGE_BYTES = 8 * HTB, NXCD = 8, WGM = 8;

__host__ __device__ __forceinline__ int lds_byte(int r, int c) { const int st = (r >> 4) * 2 + (c >> 5), rr = r & 15, cc = c & 31, ob = rr * 64 + cc * 2; return st * 1024 + (ob ^ (((ob >> 9) & 1) << 5)); }
__host__ __device__ __forceinline__ void stage_rc(int b, int& R, int& C) { const int st = b / 1024, sb = b % 1024, swz = sb ^ (((sb >> 9) & 1) << 5); R = (st >> 1) * 16 + swz / 64; C = (st & 1) * 32 + (swz % 64) / 2; }
__host__ __device__ __forceinline__ int perm32(int rho) { const int n = rho >> 4, i = rho & 15; return 8 * (i >> 2) + 4 * n + (i & 3); }

struct Unit { int pm, pn; };
struct Gemm { const bf16_t* A; const bf16_t* Bt; int M, N, K; };

struct StaticOrder {
    int nM, nN, nwg, G, c;
    __host__ __device__ void init(int M, int N, int G_, int c_) { nM = M / BM; nN = N / BM; nwg = nM * nN; G = G_; c = c_; }
    __host__ __device__ bool next(int i, Unit& u) const {
        const long L = (long)i * G + c; if (L >= nwg) return false;
        int wgid = (int)L; { const int q = nwg / NXCD, r = nwg % NXCD, xcd = wgid % NXCD, off = wgid / NXCD; wgid = (xcd < r ? xcd * (q + 1) : r * (q + 1) + (xcd - r) * q) + off; }
        const int nig = WGM * nN, gid = wgid / nig, fm = gid * WGM, gsz = (nM - fm) < WGM ? (nM - fm) : WGM;
        u.pm = fm + ((wgid % nig) % gsz); u.pn = (wgid % nig) / gsz; return true;
    }
    __device__ __forceinline__ void a_ready(const Unit&) const {}
    __device__ __forceinline__ void done(const Unit&) const {}
};

__device__ __forceinline__ unsigned cvt_pk_bf16(float lo, float hi) { unsigned r; asm volatile("v_cvt_pk_bf16_f32 %0, %1, %2" : "=v"(r) : "v"(lo), "v"(hi)); return r; }

template <class Epi, class Sched, bool ALIGN_EPI = false, bool SP2 = false>
__device__ __forceinline__ void gemm_phase(PG8_LAS unsigned char* lds, const Gemm g, const Sched& S, const Epi& E) {
    int tid_l = threadIdx.x; asm volatile("" : "+v"(tid_l));
    const int tid = tid_l, wid = __builtin_amdgcn_readfirstlane(tid >> 6), lane = tid & 63, wr = wid >> 2, wc = wid & 3, fr = lane & 15, fq = lane >> 4;
    int K_l = g.K; asm volatile("" : "+s"(K_l)); const int K = K_l, nt = K / BK;
    unsigned voffA[2], voffB[2];
#pragma unroll
    for (int i = 0; i < 2; ++i) { int R, C; stage_rc(tid * 16 + i * 8192, R, C); const int Rb = Epi::PERM ? ((R & ~31) + perm32(R & 31)) : R;
        voffA[i] = (unsigned)(R * K + C) * 2u; voffB[i] = (unsigned)(Rb * K + C) * 2u; }
    const size_t kstep = (size_t)(BK * 2);
    const size_t hstep = (size_t)HALF * K * 2;
    const size_t tstep = 2 * hstep;
    const unsigned ldsw = (unsigned)wid * 1024u;
    const int aoff = lds_byte(wr * 64 + fr, fq * 8), boff = lds_byte(wc * 32 + fr, fq * 8);
#define PG8_SA(b, h) (((b) * 2 + (h)) * HTB)
#define PG8_SB(b, h) ((4 + (b) * 2 + (h)) * HTB)
#define PG8_STAGE(bufoff, gbase, voff) do { _Pragma("unroll") for (int _i = 0; _i < 2; ++_i) \
        __builtin_amdgcn_global_load_lds((const unsigned*)((const char*)(gbase) + (voff)[_i]), (PG8_LAS unsigned*)(lds + (bufoff) + ldsw + _i * 8192), 16, 0, 0); } while (0)
#define PG8_LDA(dst, b, h) do { _Pragma("unroll") for (int m = 0; m < 4; ++m) _Pragma("unroll") for (int k = 0; k < 2; ++k) dst[m][k] = *(const PG8_LAS bf16x8*)(lds + PG8_SA(b, h) + aoff + m * 2048 + k * 1024); } while (0)
#define PG8_LDB(dst, b, h) do { _Pragma("unroll") for (int n = 0; n < 2; ++n) _Pragma("unroll") for (int k = 0; k < 2; ++k) dst[n][k] = *(const PG8_LAS bf16x8*)(lds + PG8_SB(b, h) + boff + n * 2048 + k * 1024); } while (0)
#define PG8_MMA(ai, bj, At, Bt) do { __builtin_amdgcn_s_setprio(1); _Pragma("unroll") for (int m = 0; m < 4; ++m) _Pragma("unroll") for (int n = 0; n < 2; ++n) _Pragma("unroll") for (int k = 0; k < 2; ++k) \
        acc[ai][bj][m][n] = __builtin_amdgcn_mfma_f32_16x16x32_bf16(Bt[n][k], At[m][k], acc[ai][bj][m][n], 0, 0, 0); __builtin_amdgcn_s_setprio(0); } while (0)
#define PG8_WAIT_V(n) asm volatile("s_waitcnt vmcnt(" #n ")" ::: "memory")
#define PG8_WAIT_L(n) asm volatile("s_waitcnt lgkmcnt(" #n ")" ::: "memory")
#define PG8_BAR __builtin_amdgcn_s_barrier()
#define PG8_SCHED __builtin_amdgcn_sched_barrier(0)
    Unit cur, nxt; int ui = 0;
    if (!S.next(0, cur)) return;
    f32x4 acc[2][2][4][2];
#pragma unroll
    for (int a = 0; a < 2; ++a)
#pragma unroll
        for (int b = 0; b < 2; ++b)
#pragma unroll
            for (int m = 0; m < 4; ++m)
#pragma unroll
                for (int n = 0; n < 2; ++n) acc[a][b][m][n] = (f32x4){0.f, 0.f, 0.f, 0.f};
    bf16x8 At[4][2], B0[2][2], B1[2][2];
    const char* cA = (const char*)g.A + (size_t)cur.pm * tstep; const char* cB = (const char*)g.Bt + (size_t)cur.pn * tstep;
    S.a_ready(cur);
    if constexpr (SP2) {
        PG8_STAGE(PG8_SB(0, 0), cB, voffB); PG8_STAGE(PG8_SB(0, 1), cB + hstep, voffB); PG8_STAGE(PG8_SA(0, 0), cA, voffA); PG8_STAGE(PG8_SA(0, 1), cA + hstep, voffA);
        if (wr == 1) PG8_BAR;
        PG8_WAIT_V(2); PG8_BAR;
        PG8_STAGE(PG8_SB(1, 0), cB + kstep, voffB); PG8_STAGE(PG8_SA(1, 0), cA + kstep, voffA); PG8_STAGE(PG8_SB(1, 1), cB + hstep + kstep, voffB);
        PG8_WAIT_V(6); PG8_BAR;
    } else {
        PG8_STAGE(PG8_SB(0, 0), cB, voffB); PG8_STAGE(PG8_SA(0, 0), cA, voffA); PG8_STAGE(PG8_SB(0, 1), cB + hstep, voffB); PG8_STAGE(PG8_SA(0, 1), cA + hstep, voffA);
        if (wr == 1) PG8_BAR;
        PG8_WAIT_V(4); PG8_BAR;
        PG8_STAGE(PG8_SB(1, 0), cB + kstep, voffB); PG8_STAGE(PG8_SA(1, 0), cA + kstep, voffA); PG8_STAGE(PG8_SB(1, 1), cB + hstep + kstep, voffB);
        PG8_WAIT_V(6); PG8_BAR;
    }
    for (;;) {
        const bool has_next = S.next(ui + 1, nxt);
        const char* nA = has_next ? (const char*)g.A + (size_t)nxt.pm * tstep : cA; const char* nB = has_next ? (const char*)g.Bt + (size_t)nxt.pn * tstep : cB;
        for (int t = 0; t < nt; t += 2) {
            const bool last = (t == nt - 2);
            const char* a1 = cA + (size_t)(t + 1) * kstep;
            const char* a2 = last ? nA : cA + (size_t)(t + 2) * kstep; const char* b2 = last ? nB : cB + (size_t)(t + 2) * kstep;
            const char* a3 = a2 + kstep; const char* b3 = b2 + kstep;
            if (last && has_next) S.a_ready(nxt);
            if constexpr (SP2) {
            PG8_LDB(B0, 0, 0); PG8_LDB(B1, 0, 1); PG8_SCHED; PG8_LDA(At, 0, 0); PG8_STAGE(PG8_SA(1, 1), a1 + hstep, voffA);
            PG8_WAIT_V(8); PG8_WAIT_L(0); PG8_BAR; PG8_MMA(0, 0, At, B0); PG8_MMA(0, 1, At, B1); PG8_BAR; PG8_SCHED;
            PG8_LDA(At, 0, 1); PG8_STAGE(PG8_SB(0, 0), b2, voffB); PG8_STAGE(PG8_SB(0, 1), b2 + hstep, voffB); PG8_STAGE(PG8_SA(0, 0), a2, voffA);
            PG8_WAIT_V(8); PG8_WAIT_L(0); PG8_BAR; PG8_MMA(1, 0, At, B0); PG8_MMA(1, 1, At, B1); PG8_BAR; PG8_SCHED;
            PG8_LDB(B0, 1, 0); PG8_LDB(B1, 1, 1); PG8_SCHED; PG8_LDA(At, 1, 0); PG8_STAGE(PG8_SA(0, 1), a2 + hstep, voffA);
            PG8_WAIT_V(8); PG8_WAIT_L(0); PG8_BAR; PG8_MMA(0, 0, At, B0); PG8_MMA(0, 1, At, B1); PG8_BAR; PG8_SCHED;
            PG8_LDA(At, 1, 1); PG8_STAGE(PG8_SB(1, 0), b3, voffB); PG8_STAGE(PG8_SB(1, 1), b3 + hstep, voffB); PG8_STAGE(PG8_SA(1, 0), a3, voffA);
            PG8_WAIT_V(8); PG8_WAIT_L(0); PG8_BAR; PG8_MMA(1, 0, At, B0); PG8_MMA(1, 1, At, B1); PG8_BAR; PG8_SCHED;
            } else {
            PG8_LDB(B0, 0, 0); PG8_SCHED; PG8_LDA(At, 0, 0); PG8_STAGE(PG8_SA(1, 1), a1 + hstep, voffA);
            PG8_WAIT_L(8); PG8_BAR; PG8_WAIT_L(0); PG8_MMA(0, 0, At, B0); PG8_BAR; PG8_SCHED;
            PG8_LDB(B1, 0, 1); PG8_STAGE(PG8_SB(0, 0), b2, voffB);
            PG8_BAR; PG8_WAIT_L(0); PG8_MMA(0, 1, At, B1); PG8_BAR;
            PG8_LDA(At, 0, 1); PG8_STAGE(PG8_SA(0, 0), a2, voffA);
            PG8_BAR; PG8_WAIT_L(0); PG8_MMA(1, 0, At, B0); PG8_BAR; PG8_SCHED;
            PG8_STAGE(PG8_SB(0, 1), b2 + hstep, voffB);
            PG8_WAIT_V(6); PG8_BAR; PG8_MMA(1, 1, At, B1); PG8_BAR;
            PG8_LDB(B0, 1, 0); PG8_SCHED; PG8_LDA(At, 1, 0); PG8_STAGE(PG8_SA(0, 1), a2 + hstep, voffA);
            PG8_WAIT_L(8); PG8_BAR; PG8_WAIT_L(0); PG8_MMA(0, 0, At, B0); PG8_BAR; PG8_SCHED;
            PG8_LDB(B1, 1, 1); PG8_STAGE(PG8_SB(1, 0), b3, voffB);
            PG8_BAR; PG8_WAIT_L(0); PG8_MMA(0, 1, At, B1); PG8_BAR;
            PG8_LDA(At, 1, 1); PG8_STAGE(PG8_SA(1, 0), a3, voffA);
            PG8_BAR; PG8_WAIT_L(0); PG8_MMA(1, 0, At, B0); PG8_BAR; PG8_SCHED;
            PG8_STAGE(PG8_SB(1, 1), b3 + hstep, voffB);
            PG8_WAIT_V(6); PG8_BAR; PG8_MMA(1, 1, At, B1); PG8_BAR;
            }
        }
        if constexpr (ALIGN_EPI) { if (wr == 0) PG8_BAR; }
        E(acc, cur, wr, wc, fr, fq); S.done(cur);
        if (!has_next) break;
#pragma unroll
        for (int a = 0; a < 2; ++a)
#pragma unroll
            for (int b = 0; b < 2; ++b)
#pragma unroll
                for (int m = 0; m < 4; ++m)
#pragma unroll
                    for (int n = 0; n < 2; ++n) acc[a][b][m][n] = (f32x4){0.f, 0.f, 0.f, 0.f};
        cur = nxt; cA = nA; cB = nB; ++ui;
        if constexpr (ALIGN_EPI) { if (wr == 1) PG8_BAR; }
    }
    PG8_WAIT_V(0);
    if constexpr (!ALIGN_EPI) { if (wr == 0) PG8_BAR; }
    PG8_BAR;
#undef PG8_SA
#undef PG8_SB
#undef PG8_STAGE
#undef PG8_LDA
#undef PG8_LDB
#undef PG8_MMA
#undef PG8_WAIT_V
#undef PG8_WAIT_L
#undef PG8_BAR
#undef PG8_SCHED
}
}

using pg8::bf16_t; using pg8::bf16x8; using pg8::f32x4; using pg8::u32x4; using pg8::Unit; using pg8::cvt_pk_bf16;
typedef float f32x16 __attribute__((ext_vector_type(16)));
typedef float f32x2 __attribute__((ext_vector_type(2)));
typedef unsigned u32x2 __attribute__((ext_vector_type(2)));
typedef short s16x4 __attribute__((ext_vector_type(4)));

constexpr int DM = 1024, NTOK = 16384, NPR = 8192, FF = 2816, NMOD = 9216;
constexpr int INA_P = 1792, INC = 1536;
constexpr float EPS = 1e-6f;
constexpr float LOG2E = 1.4426950408889634f;
constexpr int GSZ = 512;

constexpr size_t MiB = 1u << 20;
constexpr size_t WS_MOD = 64 * 1024, WS_ROPE_A = 512 * 1024, WS_ROPE_C = 512 * 1024 + 8192;
constexpr size_t WS_WFFIN = 1 * MiB, WFFIN_SZ = 11 * MiB;
constexpr size_t WS_WFFOUT = 45 * MiB, WFFOUT_SZ = 5 * MiB + 512 * 1024;
constexpr size_t WS_WINA = 67 * MiB, WS_WQUP = 70 * MiB + 512 * 1024, WS_WKVUP = 71 * MiB + 512 * 1024, WS_WOUTA = 72 * MiB, WS_WINC = 74 * MiB, WS_WOUTC = 77 * MiB;
constexpr size_t WS_HB = 79 * MiB;
constexpr size_t WS_HID = 111 * MiB;
constexpr size_t WS_RAW = 111 * MiB;
constexpr size_t WS_QB0 = 111 * MiB, WS_MIX0 = 167 * MiB;
constexpr size_t WS_QB1 = 159 * MiB, WS_MIX1 = 199 * MiB;
constexpr size_t WS_CQN = 199 * MiB, WS_CKVN = 211 * MiB;
constexpr size_t WS_KB0 = 220 * MiB, WS_VT0 = 238 * MiB, WS_KB1 = 256 * MiB, WS_VT1 = 265 * MiB, WS_KR = 274 * MiB;
constexpr size_t WS_SS = 276 * MiB, WS_BIAS = 278 * MiB, WS_GM = 279 * MiB, WS_END = 280 * MiB;

constexpr size_t OUT_CKV = 16777216, OUT_KROPE = 18874368, OUT_GK = 19136512, OUT_GV = 21233664;

struct Args { const float* in[32]; float* out; unsigned char* ws; };


constexpr int LDS_PTAB = 131072 + 64, LDS_RED = 131072 + 512;
template <class T, int I> DI T* ldptr() {
    u32x2 v;
    asm volatile("ds_read_b64 %0, %1 offset:%2\n\ts_waitcnt lgkmcnt(0)" : "=v"(v) : "v"(131072u), "n"(64 + 8 * I) : "memory");
    return (T*)(((unsigned long long)(unsigned)__builtin_amdgcn_readfirstlane((int)v.y) << 32) | (unsigned long long)(unsigned)__builtin_amdgcn_readfirstlane((int)v.x));
}
#define INP(i) ldptr<const float, i>()
#define OUTP() ldptr<float, 32>()
#define WSP() ldptr<unsigned char, 33>()

typedef __bf16 bf16x2_t __attribute__((ext_vector_type(2)));
DI unsigned cvtpk_s(float lo, float hi) { f32x2 v = {lo, hi}; bf16x2_t b = __builtin_convertvector(v, bf16x2_t); return __builtin_bit_cast(unsigned, b); }

DI unsigned pk2(float lo, float hi) { return cvtpk_s(lo, hi); }
DI float bf2f(unsigned short b) { return __uint_as_float(((unsigned)b) << 16); }
DI float bflo(unsigned w) { return __uint_as_float(w << 16); }
DI float bfhi(unsigned w) { return __uint_as_float(w & 0xffff0000u); }
DI float wave_sum(float v) {
#pragma unroll
    for (int o = 1; o < 64; o <<= 1) v += __shfl_xor(v, o);
    return v;
}
DI float fast_rcp(float x) { return __builtin_amdgcn_rcpf(x); }
DI float silu_f(float a) { return a * fast_rcp(1.f + __expf(-a)); }
DI float sigmoid_f(float a) { return fast_rcp(1.f + __expf(-a)); }

struct EpiSwiglu { static constexpr bool PERM = true, AFTER_DRAIN = false;
    bf16_t* H; const float* ss; const float* bias;
    DI void operator()(const f32x4 (&acc)[2][2][4][2], const Unit& u, int wr, int wc, int fr, int fq) const {
        const int row0 = u.pm * 256 + wr * 64 + fr, col0 = u.pn * 128 + wc * 32 + 8 * fq;
        const int cond = u.pm < 32 ? 4 : ((u.pm - 32) >> 3);
        const float* bp = bias + (size_t)cond * 5632 + u.pn * 256 + wc * 32 + 8 * fq;
        const f32x4 ba0 = *(const f32x4*)(bp), ba1 = *(const f32x4*)(bp + 4), bb0 = *(const f32x4*)(bp + 128), bb1 = *(const f32x4*)(bp + 132);
#pragma unroll
        for (int ai = 0; ai < 2; ++ai)
#pragma unroll
            for (int m = 0; m < 4; ++m) {
                const int row = row0 + ai * 128 + m * 16;
                const f32x4 sp4 = *(const f32x4*)(ss + (size_t)row * 4); const float r = rsqrtf(((sp4.x + sp4.y) + (sp4.z + sp4.w)) * (1.f / DM) + EPS);
                bf16_t* p = H + (size_t)row * FF + col0;
                float h[8];
#pragma unroll
                for (int i = 0; i < 4; ++i) { const float a0 = acc[ai][0][m][0][i] * r + ba0[i], b0 = acc[ai][1][m][0][i] * r + bb0[i]; h[i] = silu_f(a0) * b0;
                                              const float a1 = acc[ai][0][m][1][i] * r + ba1[i], b1 = acc[ai][1][m][1][i] * r + bb1[i]; h[4 + i] = silu_f(a1) * b1; }
                u32x4 w; w.x = pk2(h[0], h[1]); w.y = pk2(h[2], h[3]); w.z = pk2(h[4], h[5]); w.w = pk2(h[6], h[7]);
                *(u32x4*)p = w;
            }
    }
};
struct EpiResid { static constexpr bool PERM = true, AFTER_DRAIN = false;
    const float* xlo; const float* xhi; bf16_t* X; const float* gate;
    bf16_t* XG; const float* gmn; float* ss; float coef; int wxf; int skipx; int xbf;
    DI void operator()(const f32x4 (&acc)[2][2][4][2], const Unit& u, int wr, int wc, int fr, int fq) const {
        const int row0 = u.pm * 256 + wr * 64 + fr;
        const int cond = u.pm < 32 ? 4 : ((u.pm - 32) >> 3);
        const float* gp = gate + (size_t)cond * NMOD; const float* xo = u.pm < 32 ? xlo : xhi;
        const float* gm = gmn + cond * 1024;
        const bool wx = wxf != 0;
        float rs[2][4];
#pragma unroll
        for (int ai = 0; ai < 2; ++ai)
#pragma unroll
            for (int m = 0; m < 4; ++m) rs[ai][m] = 0.f;
#pragma unroll
        for (int bj = 0; bj < 2; ++bj) {
            const int c = u.pn * 256 + bj * 128 + wc * 32 + 8 * fq;
            const f32x4 gv0 = *(const f32x4*)(gp + c) * coef, gv1 = *(const f32x4*)(gp + c + 4) * coef;
            f32x4 gm0 = (f32x4){0.f, 0.f, 0.f, 0.f}, gm1 = gm0; if (wx) { gm0 = *(const f32x4*)(gm + c); gm1 = *(const f32x4*)(gm + c + 4); }
#pragma unroll
            for (int ai = 0; ai < 2; ++ai)
#pragma unroll
                for (int m = 0; m < 4; ++m) { const size_t off = (size_t)(row0 + ai * 128 + m * 16) * DM + c;
                    f32x4 x0, x1;
                    if (xbf) { const u32x4 xw = *(const u32x4*)(X + off); x0 = (f32x4){bflo(xw.x), bfhi(xw.x), bflo(xw.y), bfhi(xw.y)}; x1 = (f32x4){bflo(xw.z), bfhi(xw.z), bflo(xw.w), bfhi(xw.w)}; }
                    else { x0 = *(const f32x4*)(xo + off); x1 = *(const f32x4*)(xo + off + 4); }
                    const f32x4 n0 = x0 + gv0 * acc[ai][bj][m][0], n1 = x1 + gv1 * acc[ai][bj][m][1];
                    if (!skipx) { u32x4 xs; xs.x = pk2(n0.x, n0.y); xs.y = pk2(n0.z, n0.w); xs.z = pk2(n1.x, n1.y); xs.w = pk2(n1.z, n1.w); __builtin_nontemporal_store(xs, (u32x4*)(X + off)); }
                    if (wx) { rs[ai][m] += ((n0.x * n0.x + n0.y * n0.y) + (n0.z * n0.z + n0.w * n0.w)) + ((n1.x * n1.x + n1.y * n1.y) + (n1.z * n1.z + n1.w * n1.w));
                        const f32x4 y0 = n0 * gm0, y1 = n1 * gm1; u32x4 w; w.x = pk2(y0.x, y0.y); w.y = pk2(y0.z, y0.w); w.z = pk2(y1.x, y1.y); w.w = pk2(y1.z, y1.w); *(u32x4*)(XG + off) = w; } }
        }
        if (wx) {
            extern __shared__ __attribute__((aligned(16))) unsigned char lds_raw[];
            __attribute__((address_space(3))) float* red = (__attribute__((address_space(3))) float*)((__attribute__((address_space(3))) unsigned char*)lds_raw + LDS_RED);
#pragma unroll
            for (int ai = 0; ai < 2; ++ai)
#pragma unroll
                for (int m = 0; m < 4; ++m) { float v = rs[ai][m]; v += __shfl_xor(v, 16); v += __shfl_xor(v, 32); if (fq == 0) red[wc * 256 + ai * 128 + wr * 64 + m * 16 + fr] = v; }
            asm volatile("s_waitcnt lgkmcnt(0)" ::: "memory"); __builtin_amdgcn_s_barrier(); asm volatile("" ::: "memory");
            const int t = (wr * 4 + wc) * 64 + fq * 16 + fr;
            if (t < 256) ss[((size_t)u.pm * 256 + t) * 4 + u.pn] = (red[t] + red[256 + t]) + (red[512 + t] + red[768 + t]);
            asm volatile("s_waitcnt lgkmcnt(0)" ::: "memory"); __builtin_amdgcn_s_barrier(); asm volatile("" ::: "memory");
        }
    }
};
template <bool NORM> struct EpiStore { static constexpr bool PERM = true, AFTER_DRAIN = false;
    bf16_t* O; int ldc; float sc; const float* ss; const float* bias;
    DI void operator()(const f32x4 (&acc)[2][2][4][2], const Unit& u, int wr, int wc, int fr, int fq) const {
        const int row0 = u.pm * 256 + wr * 64 + fr, col0 = u.pn * 256 + wc * 32 + 8 * fq;
        const int cond = u.pm < 32 ? 4 : ((u.pm - 32) >> 3);
        f32x4 bv[2][2];
#pragma unroll
        for (int bj = 0; bj < 2; ++bj)
#pragma unroll
            for (int n = 0; n < 2; ++n) bv[bj][n] = NORM ? *(const f32x4*)(bias + (size_t)cond * 5632 + col0 + bj * 128 + 4 * n) : (f32x4){0.f, 0.f, 0.f, 0.f};
#pragma unroll
        for (int ai = 0; ai < 2; ++ai)
#pragma unroll
            for (int m = 0; m < 4; ++m) {
                const int row = row0 + ai * 128 + m * 16;
                float r = sc; if (NORM) { const f32x4 sp4 = *(const f32x4*)(ss + (size_t)row * 4); r = rsqrtf(((sp4.x + sp4.y) + (sp4.z + sp4.w)) * (1.f / DM) + EPS); }
#pragma unroll
                for (int bj = 0; bj < 2; ++bj) {
                    const f32x4 v0 = acc[ai][bj][m][0] * r + bv[bj][0], v1 = acc[ai][bj][m][1] * r + bv[bj][1];
                    u32x4 w; w.x = pk2(v0[0], v0[1]); w.y = pk2(v0[2], v0[3]); w.z = pk2(v1[0], v1[1]); w.w = pk2(v1[2], v1[3]);
                    *(u32x4*)(O + (size_t)row * ldc + col0 + bj * 128) = w;
                }
            }
    }
};
struct EpiKVup { static constexpr bool PERM = true, AFTER_DRAIN = false;
    bf16_t* KB; bf16_t* VT;
    DI void operator()(const f32x4 (&acc)[2][2][4][2], const Unit& u, int wr, int wc, int fr, int fq) const {
        const int row0 = u.pm * 256 + wr * 64 + fr;
        unsigned kb0, Sk; int key0;
        if (u.pm < 32) { const int s = u.pm; key0 = 0; Sk = 256; kb0 = (unsigned)(s * 8) * 256u; }
        else { int b, k; if (u.pm < 64) { const int t = (u.pm - 32) * 256; b = t >> 11; k = 512 + (t & 2047); } else { const int t = (u.pm - 64) * 256; b = t >> 9; k = t & 511; }
            key0 = k; Sk = 2560; kb0 = 32u * 8u * 256u + (unsigned)(b * 8) * 2560u; }
        const int keyl = key0 + wr * 64 + fr;
#pragma unroll
        for (int bj = 0; bj < 2; ++bj) {
            const unsigned h = u.pn * 2 + bj;
#pragma unroll
            for (int ai = 0; ai < 2; ++ai)
#pragma unroll
                for (int m = 0; m < 4; ++m) {
                    const unsigned key = keyl + ai * 128 + m * 16;
                    const f32x4 v0 = acc[ai][bj][m][0], v1 = acc[ai][bj][m][1];
                    const unsigned a = cvtpk_s(v0[0], v0[1]), b2 = cvtpk_s(v0[2], v0[3]), c = cvtpk_s(v1[0], v1[1]), d = cvtpk_s(v1[2], v1[3]);
                    { u32x4 w; w.x = a; w.y = b2; w.z = c; w.w = d;
                      bf16_t* dst = (wc < 2) ? KB : VT;
                      *(u32x4*)(dst + (size_t)((kb0 + h * Sk + key) * 64u + (wc & 1) * 32 + 8 * fq)) = w; }
                    asm volatile("" ::: "memory");
                }
        }
    }
};

DI void transpose_item(const float* W, int K, int N, bf16_t* WT, bool ffmode, float* scr, int item, int lane) {
    const int nblk = N / 32, kb = item / nblk, nb = item % nblk, k0 = 64 * kb, n0 = 32 * nb;
    const int lk = lane >> 3, ln = (lane & 7) * 4;
    f32x4 v[8];
#pragma unroll
    for (int i = 0; i < 8; ++i) v[i] = __builtin_nontemporal_load((const f32x4*)(W + (size_t)(k0 + lk + 8 * i) * N + n0 + ln));
#pragma unroll
    for (int i = 0; i < 8; ++i) { float* d = scr + (lk + 8 * i) * 33 + ln; d[0] = v[i].x; d[1] = v[i].y; d[2] = v[i].z; d[3] = v[i].w; }
    asm volatile("s_waitcnt lgkmcnt(0)" ::: "memory");
    int rbase = n0;
    if (ffmode) { const bool isb = n0 >= FF; const int j0 = isb ? n0 - FF : n0; rbase = (j0 >> 7) * 256 + (isb ? 128 : 0) + (j0 & 127); }
    const int c = lane & 7;
#pragma unroll
    for (int j = 0; j < 4; ++j) { const int n = (lane >> 3) + 8 * j; const float* s = scr + (8 * c) * 33 + n;
        u32x4 o; o.x = pk2(s[0 * 33], s[1 * 33]); o.y = pk2(s[2 * 33], s[3 * 33]); o.z = pk2(s[4 * 33], s[5 * 33]); o.w = pk2(s[6 * 33], s[7 * 33]);
        *(u32x4*)(WT + (size_t)(rbase + n) * K + k0 + 8 * c) = o; }
    asm volatile("s_waitcnt lgkmcnt(0)" ::: "memory");
}

DI void transpose_set(int set, char* lds, int widx, int nw, int lane, int wave) {
    unsigned char* ws = WSP(); asm volatile("" : "+s"(ws));
    float* scr = (float*)(lds + 61440 + wave * 8704);
    constexpr int I_FI = 16 * 176, I_FO = 44 * 32, I_INA = 16 * 53, I_QU = 6 * 24, I_KV = 4 * 32, I_OA = 16 * 32, I_IC = 16 * 48, I_OC = 16 * 32;
    const int f = set, l = f >> 1, wh = f & 1;
    const int nextra = (set == 0) ? (I_INA + I_QU + I_KV + I_OA) : (set == 2 ? I_IC + I_OC : 0);
    const int nitems = I_FI + I_FO + nextra;
    for (int it = widx; it < nitems; it += nw) {
        int r = it;
        if (r < I_FI) { transpose_item((wh ? INP(13) : INP(9)) + (size_t)l * DM * 2 * FF, DM, 2 * FF, (bf16_t*)(ws + WS_WFFIN + f * WFFIN_SZ), true, scr, r, lane); continue; } r -= I_FI;
        if (r < I_FO) { transpose_item((wh ? INP(14) : INP(10)) + (size_t)l * FF * DM, FF, DM, (bf16_t*)(ws + WS_WFFOUT + f * WFFOUT_SZ), false, scr, r, lane); continue; } r -= I_FO;
        if (set == 0) {
            if (r < I_INA) { transpose_item(INP(17), DM, 1696, (bf16_t*)(ws + WS_WINA), false, scr, r, lane); continue; } r -= I_INA;
            if (r < I_QU) { transpose_item(INP(19), 384, 768, (bf16_t*)(ws + WS_WQUP), false, scr, r, lane); continue; } r -= I_QU;
            if (r < I_KV) { transpose_item(INP(21), 256, 1024, (bf16_t*)(ws + WS_WKVUP), false, scr, r, lane); continue; } r -= I_KV;
            transpose_item(INP(26), DM, DM, (bf16_t*)(ws + WS_WOUTA), false, scr, r, lane);
        } else {
            if (r < I_IC) { transpose_item(INP(27), DM, INC, (bf16_t*)(ws + WS_WINC), false, scr, r, lane); continue; } r -= I_IC;
            transpose_item(INP(30), DM, DM, (bf16_t*)(ws + WS_WOUTC), false, scr, r, lane);
        }
    }
}
DI void bias_rows(int k, int lane, int gw, int NGW) {
    unsigned char* ws = WSP(); asm volatile("" : "+s"(ws));
    const float* MOD = (const float*)(ws + WS_MOD);
    float* BIAS = (float*)(ws + WS_BIAS);
    const int l = k / 3, w3 = k % 3;
    const int Nk = (w3 == 1) ? (l ? INC : INA_P) : 2 * FF;
    const bf16_t* Wt = (const bf16_t*)(ws + (w3 == 1 ? (l ? WS_WINC : WS_WINA) : WS_WFFIN + (size_t)(2 * l + (w3 == 2 ? 1 : 0)) * WFFIN_SZ));
    float shv[5][16];
#pragma unroll
    for (int c = 0; c < 5; ++c) { const float* sp = MOD + (size_t)(l * 5 + c) * NMOD + (3 * w3) * 1024;
#pragma unroll
        for (int h = 0; h < 2; ++h) { const f32x4 s0 = *(const f32x4*)(sp + h * 512 + lane * 8), s1 = *(const f32x4*)(sp + h * 512 + lane * 8 + 4);
#pragma unroll
            for (int i = 0; i < 4; ++i) { shv[c][h * 8 + i] = s0[i]; shv[c][h * 8 + 4 + i] = s1[i]; } } }
    for (int row = gw; row < Nk; row += NGW) {
        const u32x4 w0 = *(const u32x4*)(Wt + (size_t)row * DM + lane * 8), w1 = *(const u32x4*)(Wt + (size_t)row * DM + 512 + lane * 8);
        float wv[16];
#pragma unroll
        for (int i = 0; i < 4; ++i) { wv[2 * i] = bflo(w0[i]); wv[2 * i + 1] = bfhi(w0[i]); wv[8 + 2 * i] = bflo(w1[i]); wv[8 + 2 * i + 1] = bfhi(w1[i]); }
#pragma unroll
        for (int c = 0; c < 5; ++c) { float d = 0.f;
#pragma unroll
            for (int i = 0; i < 16; ++i) d += wv[i] * shv[c][i];
            d = wave_sum(d);
            if (lane == 0) BIAS[(size_t)(k * 5 + c) * 5632 + row] = d; }
    }
}
#define FRESH_IDS int tid_l = threadIdx.x; asm volatile("" : "+v"(tid_l)); const int tid = tid_l, lane = tid & 63, wave = __builtin_amdgcn_readfirstlane(tid >> 6); (void)tid; (void)lane; (void)wave;
DI void phase0(char* lds) {
    FRESH_IDS
    unsigned char* ws = WSP(); asm volatile("" : "+s"(ws));
    const int G = gridDim.x;
    {
        float* eL = (float*)lds;
        float* part = (float*)(lds + 20480);
        float* MOD = (float*)(ws + WS_MOD);
        bool have = false;
        for (int task = blockIdx.x; task < 288; task += G) {
            if (!have) {
                for (int idx = tid; idx < 5120; idx += GSZ) { const int c = idx >> 10, k = idx & 1023; const float v = (c < 4) ? INP(6)[c * 1024 + k] : INP(7)[k]; eL[idx] = silu_f(v); }
                have = true;
            }
            __syncthreads();
            const int kh = task & 1, t2 = task >> 1, l = t2 / 72, n0 = (t2 % 72) * 128;
            const int kbase = kh * 512 + wave * 64;
            const float* wp = INP(15) + ((size_t)l * 1024 + kbase) * NMOD + n0 + 2 * lane;
            f32x2 acc[5];
#pragma unroll
            for (int c = 0; c < 5; ++c) acc[c] = (f32x2){0.f, 0.f};
            for (int k = 0; k < 64; k += 8) {
                f32x2 wv[8];
#pragma unroll
                for (int j = 0; j < 8; ++j) wv[j] = __builtin_nontemporal_load((const f32x2*)(wp + (size_t)(k + j) * NMOD));
#pragma unroll
                for (int j = 0; j < 8; ++j)
#pragma unroll
                    for (int c = 0; c < 5; ++c) { const float e = eL[c * 1024 + kbase + k + j]; acc[c] += wv[j] * e; }
            }
#pragma unroll
            for (int c = 0; c < 5; ++c) *(f32x2*)(part + (wave * 5 + c) * 128 + 2 * lane) = acc[c];
            __syncthreads();
            for (int idx = tid; idx < 640; idx += GSZ) { const int c = idx >> 7, n = idx & 127; float sacc = (kh == 0) ? INP(16)[l * NMOD + n0 + n] : 0.f;
#pragma unroll
                for (int w = 0; w < 8; ++w) sacc += part[(w * 5 + c) * 128 + n];
                atomicAdd(MOD + (size_t)(l * 5 + c) * NMOD + n0 + n, sacc); }
        }
        __syncthreads();
    }
    transpose_set(0, lds, blockIdx.x * 8 + wave, G * 8, lane, wave);
    {
        const int gt = blockIdx.x * GSZ + tid, NT = G * GSZ;
        { u32x4* z = (u32x4*)(ws + WS_WINA + (size_t)1696 * DM * 2); for (int i = gt; i < 96 * DM * 2 / 16; i += NT) z[i] = (u32x4){0u, 0u, 0u, 0u}; }
        { bf16_t* dst = (bf16_t*)(ws + WS_CKVN) + (size_t)NTOK * 256;
          for (int i = gt; i < 2048 * 256 / 4; i += NT) { const f32x4 v = *(const f32x4*)(INP(2) + (size_t)i * 4); u32x2 w; w.x = pk2(v[0], v[1]); w.y = pk2(v[2], v[3]); *(u32x2*)(dst + (size_t)i * 4) = w; } }
        { bf16_t* dst = (bf16_t*)(ws + WS_KR) + (size_t)NPR * 32;
          for (int i = gt; i < 2048 * 32 / 4; i += NT) { const int e = i * 4, b = e >> 14, rem = e & 16383; const f32x4 v = *(const f32x4*)(INP(3) + e); u32x2 w; w.x = pk2(v[0], v[1]); w.y = pk2(v[2], v[3]);
              *(u32x2*)(dst + (size_t)b * 2560 * 32 + rem) = w; } }
        { bf16_t* dst = (bf16_t*)(ws + WS_KB1) + (size_t)32 * 4 * 256 * 64;
          for (int i = gt; i < 2048 * 256 / 4; i += NT) { const int e = i * 4, d = e & 63, kvh = (e >> 6) & 3, key = (e >> 8) & 511, b = e >> 17; const f32x4 v = *(const f32x4*)(INP(4) + e);
              u32x2 w; w.x = pk2(v[0], v[1]); w.y = pk2(v[2], v[3]); *(u32x2*)(dst + ((size_t)(b * 4 + kvh) * 2560 + key) * 64 + d) = w; } }
        { bf16_t* dst = (bf16_t*)(ws + WS_VT1) + (size_t)32 * 4 * 256 * 64;
          for (int i = gt; i < 2048 * 256 / 4; i += NT) { const int e = i * 4, d = e & 63, kvh = (e >> 6) & 3, key = (e >> 8) & 511, b = e >> 17; const f32x4 v = *(const f32x4*)(INP(5) + e);
              u32x2 w; w.x = pk2(v[0], v[1]); w.y = pk2(v[2], v[3]); *(u32x2*)(dst + ((size_t)(b * 4 + kvh) * 2560 + key) * 64 + d) = w; } }
        if (gt < 64 * 24) {
            const int pos = gt / 24, fi = gt % 24; const bool isA = fi < 8; const int f = isA ? fi : fi - 8;
            const double c16 = 0.5623413251903491;
            double inv = 1.0; const int pw = isA ? 2 * f : f;
            for (int i = 0; i < pw; ++i) inv *= c16;
            const double ang = (double)pos * inv; const double twopi = 6.283185307179586476925;
            const double x = ang - twopi * __builtin_rint(ang / twopi);
            const double x2 = x * x; double sn = 0.0, cs = 0.0, ts = x, tc = 1.0;
            for (int k = 0; k < 14; ++k) { sn += ts; cs += tc; tc = -tc * x2 / (double)((2 * k + 1) * (2 * k + 2)); ts = -ts * x2 / (double)((2 * k + 2) * (2 * k + 3)); }
            f32x2* T = isA ? (f32x2*)(ws + WS_ROPE_A) + pos * 8 + f : (f32x2*)(ws + WS_ROPE_C) + pos * 16 + f;
            *T = (f32x2){(float)cs, (float)sn};
        }
    }
}

DI void p0b_phase() {
    FRESH_IDS
    unsigned char* ws = WSP(); asm volatile("" : "+s"(ws));
    const float* MOD = (const float*)(ws + WS_MOD);
    const int G = gridDim.x, NGW = G * 8, gw = blockIdx.x * 8 + wave;
    {
        float* GM = (float*)(ws + WS_GM);
        for (int i = blockIdx.x * GSZ + tid; i < 7 * 5 * 1024; i += G * GSZ) {
            const int e = i & 1023, cond = (i >> 10) % 5, k = i / 5120, l = k / 3, w3 = k % 3;
            if (k == 6) { GM[i] = INP(31)[e]; continue; }
            const float* g = (w3 == 0 ? INP(8) : (w3 == 1 ? INP(11) : INP(12))) + l * DM;
            GM[i] = g[e] * (1.f + MOD[(size_t)(l * 5 + cond) * NMOD + (3 * w3 + 1) * 1024 + e]);
        }
    }
    bias_rows(0, lane, gw, NGW); bias_rows(1, lane, gw, NGW);
    {
        bf16_t* HB = (bf16_t*)(ws + WS_HB); float* SS0 = (float*)(ws + WS_SS);
        const float* g = INP(8);
        for (int rb = gw; rb < NTOK / 8; rb += NGW) {
            const int cond = rb < 1024 ? 4 : ((rb - 1024) >> 8);
            const float* mp = MOD + (size_t)cond * NMOD;
            const float* xs = rb < 1024 ? INP(0) : INP(1) - (size_t)NPR * DM;
            f32x4 gm[4];
#pragma unroll
            for (int j = 0; j < 4; ++j) { const int e = 4 * lane + 256 * j; const f32x4 gv = *(const f32x4*)(g + e), sc = *(const f32x4*)(mp + 1024 + e); gm[j] = gv * (sc + 1.0f); }
            for (int r = 0; r < 8; ++r) {
                const size_t row = (size_t)rb * 8 + r;
                const f32x4* xr = (const f32x4*)(xs + row * DM) + lane;
                f32x4 v[4]; float ssq = 0.f;
#pragma unroll
                for (int j = 0; j < 4; ++j) { v[j] = xr[64 * j]; ssq += (v[j].x * v[j].x + v[j].y * v[j].y) + (v[j].z * v[j].z + v[j].w * v[j].w); }
                ssq = wave_sum(ssq);
                if (lane == 0) *(f32x4*)(SS0 + row * 4) = (f32x4){ssq, 0.f, 0.f, 0.f};
                u32x2* o = (u32x2*)(HB + row * DM) + lane;
#pragma unroll
                for (int j = 0; j < 4; ++j) { const f32x4 y = v[j] * gm[j]; u32x2 w; w.x = pk2(y.x, y.y); w.y = pk2(y.z, y.w); o[64 * j] = w; }
            }
        }
    }
}
DI void final_phase() {
    FRESH_IDS
    unsigned char* ws = WSP(); asm volatile("" : "+s"(ws));
    const bf16_t* XG = (const bf16_t*)(ws + WS_HB); const float* SS6 = (const float*)(ws + WS_SS) + (size_t)6 * NTOK * 4;
    float* out = OUTP();
    const int NGW = gridDim.x * 8;
    for (int row = blockIdx.x * 8 + wave; row < NTOK; row += NGW) {
        const f32x4 sp4 = *(const f32x4*)(SS6 + (size_t)row * 4);
        const float rstd = rsqrtf(((sp4.x + sp4.y) + (sp4.z + sp4.w)) * (1.f / DM) + EPS);
        const u32x2* xr = (const u32x2*)(XG + (size_t)row * DM) + lane;
        f32x4* orow = (f32x4*)(out + (size_t)row * DM) + lane;
        u32x2 v[4];
#pragma unroll
        for (int j = 0; j < 4; ++j) v[j] = xr[64 * j];
#pragma unroll
        for (int j = 0; j < 4; ++j) orow[64 * j] = (f32x4){bflo(v[j].x), bfhi(v[j].x), bflo(v[j].y), bfhi(v[j].y)} * rstd;
    }
}

DI void e1_phase(char* lds) {
    FRESH_IDS
    unsigned char* ws = WSP(); asm volatile("" : "+s"(ws));
    const bf16_t* RAW = (const bf16_t*)(ws + WS_RAW);
    bf16_t* CQN = (bf16_t*)(ws + WS_CQN); bf16_t* CKVN = (bf16_t*)(ws + WS_CKVN); bf16_t* KR = (bf16_t*)(ws + WS_KR);
    bf16_t* MIX = (bf16_t*)(ws + WS_MIX0);
    const f32x2* ropeA = (const f32x2*)(ws + WS_ROPE_A);
    const int G = gridDim.x, NGW = G * 8;
    {
        const float* gq = INP(18); const float* gkv = INP(20);
        float gql[6]; f32x4 gk4;
#pragma unroll
        for (int j = 0; j < 3; ++j) { gql[2 * j] = gq[2 * lane + 128 * j]; gql[2 * j + 1] = gq[2 * lane + 128 * j + 1]; }
        gk4 = *(const f32x4*)(gkv + 4 * lane);
        float* outp = OUTP();
        int t = blockIdx.x * 8 + wave;
        unsigned cw[3]; u32x2 kw; unsigned short krw;
        if (t < NTOK) { const bf16_t* rr = RAW + (size_t)t * INA_P;
#pragma unroll
            for (int j = 0; j < 3; ++j) cw[j] = *(const unsigned*)(rr + 2 * lane + 128 * j);
            kw = *(const u32x2*)(rr + 384 + 4 * lane); krw = rr[640 + (lane & 31)]; }
        for (; t < NTOK; t += NGW) {
            unsigned cwn[3]; u32x2 kwn; unsigned short krn; const int tn = t + NGW;
            if (tn < NTOK) { const bf16_t* rn = RAW + (size_t)tn * INA_P;
#pragma unroll
                for (int j = 0; j < 3; ++j) cwn[j] = *(const unsigned*)(rn + 2 * lane + 128 * j);
                kwn = *(const u32x2*)(rn + 384 + 4 * lane); krn = rn[640 + (lane & 31)]; }
            float ss = 0.f;
#pragma unroll
            for (int j = 0; j < 3; ++j) { const float x0 = bflo(cw[j]), x1 = bfhi(cw[j]); ss += x0 * x0 + x1 * x1; }
            f32x4 kv = (f32x4){bflo(kw.x), bfhi(kw.x), bflo(kw.y), bfhi(kw.y)};
            float sk = (kv.x * kv.x + kv.y * kv.y) + (kv.z * kv.z + kv.w * kv.w);
#pragma unroll
            for (int o = 1; o < 64; o <<= 1) { ss += __shfl_xor(ss, o); sk += __shfl_xor(sk, o); }
            const float rq = rsqrtf(ss * (1.f / 384.f) + EPS);
#pragma unroll
            for (int j = 0; j < 3; ++j) *(unsigned*)(CQN + (size_t)t * 384 + 2 * lane + 128 * j) = pk2(bflo(cw[j]) * rq * gql[2 * j], bfhi(cw[j]) * rq * gql[2 * j + 1]);
            const float rk = rsqrtf(sk * (1.f / 256.f) + EPS);
            kv = kv * rk * gk4;
            if (t < NPR) *(f32x4*)(outp + OUT_CKV + (size_t)t * 256 + 4 * lane) = kv;
            { u32x2 w; w.x = pk2(kv.x, kv.y); w.y = pk2(kv.z, kv.w); *(u32x2*)(CKVN + (size_t)t * 256 + 4 * lane) = w; }
            {
                const float v = bf2f(krw);
                if (t < NPR) {
                    if (lane < 32) { outp[OUT_KROPE + (size_t)t * 32 + lane] = v; KR[(size_t)t * 32 + lane] = krw; }
                } else {
                    const int uu = t - NPR, b = uu >> 11, p = uu & 2047; const int j = lane & 31; const int pos = (j < 16) ? (p >> 6) : (p & 63);
                    const float o = __shfl_xor(v, 8); const f32x2 cs = ropeA[pos * 8 + (j & 7)];
                    const float y = (j & 8) ? (v * cs.x + o * cs.y) : (v * cs.x - o * cs.y);
                    if (lane < 32) KR[(size_t)NPR * 32 + ((size_t)b * 2560 + 512 + p) * 32 + lane] = (bf16_t)(pk2(y, 0.f) & 0xffff);
                }
            }
#pragma unroll
            for (int j = 0; j < 3; ++j) cw[j] = cwn[j];
            kw = kwn; krw = krn;
        }
    }
    {
        bf16_t* gls = (bf16_t*)lds;
        float* cv = (float*)(lds + 63488);
        const int c = tid;
        float w[31];
#pragma unroll
        for (int j = 0; j < 31; ++j) w[j] = INP(22)[j * 512 + c];
        const float bdw = INP(23)[c];
        float gln[8], bln[8];
#pragma unroll
        for (int i = 0; i < 8; ++i) { gln[i] = INP(24)[lane * 8 + i]; bln[i] = INP(25)[lane * 8 + i]; }
        for (int tile = blockIdx.x; tile < NTOK / 32; tile += G) {
            const int t0 = tile * 32;
            int s0, s1;
            if (t0 < NPR) { s0 = t0 & ~255; s1 = s0 + 256; } else { s0 = NPR + ((t0 - NPR) & ~2047); s1 = s0 + 2048; }
            u32x4 av[8], bv[8];
#pragma unroll
            for (int k = 0; k < 8; ++k) { const int i = wave + 8 * k; int tt = t0 - 15 + i; tt = tt < s0 ? s0 : (tt >= s1 ? s1 - 1 : tt);
                const bf16_t* rr = RAW + (size_t)tt * INA_P + 672 + lane * 8; av[k] = *(const u32x4*)rr; bv[k] = *(const u32x4*)(rr + 512); }
#pragma unroll
            for (int k = 0; k < 8; ++k) { const int i = wave + 8 * k; const int tt = t0 - 15 + i; const bool valid = (tt >= s0) && (tt < s1);
                u32x4 o;
#pragma unroll
                for (int e = 0; e < 4; ++e) { const float g0 = bflo(av[k][e]) * sigmoid_f(bflo(bv[k][e])), g1 = bfhi(av[k][e]) * sigmoid_f(bfhi(bv[k][e])); o[e] = valid ? pk2(g0, g1) : 0u; }
                if (i < 62) *(u32x4*)(gls + i * 512 + lane * 8) = o; }
            __syncthreads();
            float acc[32];
#pragma unroll
            for (int o = 0; o < 32; ++o) acc[o] = bdw;
#pragma unroll
            for (int i = 0; i < 62; ++i) {
                const float gl = bf2f(gls[i * 512 + c]);
#pragma unroll
                for (int o = 0; o < 32; ++o) { const int j = i - o; if (j >= 0 && j < 31) acc[o] += w[j] * gl; }
            }
#pragma unroll
            for (int o = 0; o < 32; ++o) cv[o * 512 + c] = acc[o];
            __syncthreads();
#pragma unroll
            for (int q = 0; q < 4; ++q) {
                const int o = wave * 4 + q;
                float v[8]; float sm = 0.f;
                { const f32x4 c0 = *(const f32x4*)(cv + o * 512 + lane * 8), c1 = *(const f32x4*)(cv + o * 512 + lane * 8 + 4);
                  v[0] = c0.x; v[1] = c0.y; v[2] = c0.z; v[3] = c0.w; v[4] = c1.x; v[5] = c1.y; v[6] = c1.z; v[7] = c1.w; }
#pragma unroll
                for (int i = 0; i < 8; ++i) sm += v[i];
                const float mu = wave_sum(sm) * (1.f / 512.f); float s2 = 0.f;
#pragma unroll
                for (int i = 0; i < 8; ++i) { v[i] -= mu; s2 += v[i] * v[i]; }
                const float rstd = rsqrtf(wave_sum(s2) * (1.f / 512.f) + EPS);
                float y[8];
#pragma unroll
                for (int i = 0; i < 8; ++i) y[i] = silu_f(v[i] * rstd * gln[i] + bln[i]);
                u32x4 w; w.x = pk2(y[0], y[1]); w.y = pk2(y[2], y[3]); w.z = pk2(y[4], y[5]); w.w = pk2(y[6], y[7]);
                *(u32x4*)(MIX + (size_t)(t0 + o) * DM + 512 + lane * 8) = w;
            }
        }
        __syncthreads();
    }
}

DI void e2_phase() {
    FRESH_IDS
    unsigned char* ws = WSP(); asm volatile("" : "+s"(ws));
    const bf16_t* RAW = (const bf16_t*)(ws + WS_RAW);
    bf16_t* QB = (bf16_t*)(ws + WS_QB1); bf16_t* KB = (bf16_t*)(ws + WS_KB1); bf16_t* VB = (bf16_t*)(ws + WS_VT1);
    const f32x2* ropeC = (const f32x2*)(ws + WS_ROPE_C);
    float* out = OUTP();
    const int NGW = gridDim.x * 8;
    const int sub = lane & 7, hsel = lane >> 3;
    float gq[8], gk[8];
#pragma unroll
    for (int i = 0; i < 8; ++i) { gq[i] = INP(28)[sub * 8 + i]; gk[i] = INP(29)[sub * 8 + i]; }
    const float qs = 0.125f * LOG2E;
    int t = blockIdx.x * 8 + wave;
    u32x4 w[3];
    if (t < NTOK) {
#pragma unroll
        for (int j = 0; j < 3; ++j) w[j] = *(const u32x4*)(RAW + (size_t)t * INC + j * 512 + lane * 8);
    }
    for (; t < NTOK; t += NGW) {
        u32x4 wn[3];
        const int tn = t + NGW;
        if (tn < NTOK) {
#pragma unroll
            for (int j = 0; j < 3; ++j) wn[j] = *(const u32x4*)(RAW + (size_t)tn * INC + j * 512 + lane * 8);
        }
        const bool lat = t >= NPR;
        int p = 0, key, Sk; unsigned kbase;
        if (!lat) { const int sq = t >> 8; key = t & 255; Sk = 256; kbase = (unsigned)sq * 4u * 256u; }
        else { const int uu = t - NPR, b = uu >> 11; p = uu & 2047; key = 512 + p; Sk = 2560; kbase = 32u * 4u * 256u + (unsigned)b * 4u * 2560u; }
        f32x2 cs[8];
        if (lat) { const int pos = (sub & 4) ? (p & 63) : (p >> 6); const f32x2* rp = ropeC + pos * 16 + (sub & 1) * 8;
#pragma unroll
            for (int i = 0; i < 8; ++i) cs[i] = rp[i]; }
        else {
#pragma unroll
            for (int i = 0; i < 8; ++i) cs[i] = (f32x2){1.f, 0.f}; }
#pragma unroll
        for (int j = 0; j < 3; ++j) {
            float v[8];
#pragma unroll
            for (int i = 0; i < 4; ++i) { v[2 * i] = bflo(w[j][i]); v[2 * i + 1] = bfhi(w[j][i]); }
            const bool isv = (j == 2) && (hsel >= 4);
            const bool isk = (j == 2) && (hsel < 4);
            float ss = 0.f;
#pragma unroll
            for (int i = 0; i < 8; ++i) ss += v[i] * v[i];
            ss += __shfl_xor(ss, 1); ss += __shfl_xor(ss, 2); ss += __shfl_xor(ss, 4);
            const float rs = rsqrtf(ss * (1.f / 64.f) + EPS);
            float nv[8], y[8];
#pragma unroll
            for (int i = 0; i < 8; ++i) nv[i] = v[i] * rs * (j == 2 ? gk[i] : gq[i]);
#pragma unroll
            for (int i = 0; i < 8; ++i) { const float o = __shfl_xor(nv[i], 2); y[i] = (sub & 2) ? (nv[i] * cs[i].x + o * cs[i].y) : (nv[i] * cs[i].x - o * cs[i].y); }
            if (j < 2) {
                u32x4 o4; o4.x = pk2(y[0] * qs, y[1] * qs); o4.y = pk2(y[2] * qs, y[3] * qs); o4.z = pk2(y[4] * qs, y[5] * qs); o4.w = pk2(y[6] * qs, y[7] * qs);
                *(u32x4*)(QB + (size_t)t * DM + (8 * j + hsel) * 64 + sub * 8) = o4;
            } else if (isk) {
                const int kvh = hsel;
                u32x4 o4; o4.x = pk2(y[0], y[1]); o4.y = pk2(y[2], y[3]); o4.z = pk2(y[4], y[5]); o4.w = pk2(y[6], y[7]);
                *(u32x4*)(KB + (size_t)(kbase + (unsigned)kvh * Sk + key) * 64 + sub * 8) = o4;
                if (!lat) { float* op = out + OUT_GK + (size_t)t * 256 + kvh * 64 + sub * 8; *(f32x4*)op = (f32x4){nv[0], nv[1], nv[2], nv[3]}; *(f32x4*)(op + 4) = (f32x4){nv[4], nv[5], nv[6], nv[7]}; }
            } else if (isv) {
                const int kvh = hsel - 4;
                *(u32x4*)(VB + (size_t)(kbase + (unsigned)kvh * Sk + key) * 64 + sub * 8) = w[2];
                if (!lat) { float* op = out + OUT_GV + (size_t)t * 256 + kvh * 64 + sub * 8; *(f32x4*)op = (f32x4){v[0], v[1], v[2], v[3]}; *(f32x4*)(op + 4) = (f32x4){v[4], v[5], v[6], v[7]}; }
            }
        }
#pragma unroll
        for (int j = 0; j < 3; ++j) w[j] = wn[j];
    }
}

#define GAS1 __attribute__((address_space(1)))
template <int DK>
DI void attn_unit(char* lds, const bf16_t* Qp, int qpitch, const bf16_t* Kh, const bf16_t* KRs, const bf16_t* VTh, int Sk, bf16_t* Op, int tid, int lane, int wave, const f32x2* ropeA, int pos0) {
    constexpr int DKP = DK + 8, KROW = DKP * 2, KT_B = 128 * KROW, VT_B = 128 * 144, BUF_B = KT_B + VT_B, NS = DK / 16;
    const int q = lane & 31, hi = lane >> 5;
    bf16x8 qf[NS];
#pragma unroll
    for (int s = 0; s < NS; ++s) qf[s] = *(const GAS1 bf16x8*)(Qp + (size_t)(wave * 32 + q) * qpitch + s * 16 + hi * 8);
    if (DK == 96) { if (ropeA) {
        const int p = pos0 + wave * 32 + q;
#pragma unroll
        for (int s = 4; s < 6; ++s) {
            const int pos = (s == 4) ? (p >> 6) : (p & 63);
            const u32x4 w = __builtin_bit_cast(u32x4, qf[s < NS ? s : 0]); u32x4 r;
#pragma unroll
            for (int j = 0; j < 4; ++j) {
                const unsigned wj = w[j]; const float x0 = bflo(wj), x1 = bfhi(wj);
                const float y0 = __shfl_xor(x0, 32), y1 = __shfl_xor(x1, 32);
                const f32x2 c0 = ((const GAS1 f32x2*)ropeA)[pos * 8 + 2 * j], c1 = ((const GAS1 f32x2*)ropeA)[pos * 8 + 2 * j + 1];
                const float z0 = hi ? (x0 * c0.x + y0 * c0.y) : (x0 * c0.x - y0 * c0.y);
                const float z1 = hi ? (x1 * c1.x + y1 * c1.y) : (x1 * c1.x - y1 * c1.y);
                r[j] = cvtpk_s(z0, z1);
            }
            qf[s < NS ? s : 0] = __builtin_bit_cast(bf16x8, r);
        }
    } }
    f32x16 o0, o1;
#pragma unroll
    for (int r = 0; r < 16; ++r) { o0[r] = 0.f; o1[r] = 0.f; }
    float mrun = -1e30f, lsum = 0.f;
    const int NT = Sk / 128;
    const int kkey = tid >> 3, kch = tid & 7;
    const int rkey = tid >> 2, rch = tid & 3;
    u32x4 gk0, gk1, gr, gv0, gv1;
    gk0 = *(const GAS1 u32x4*)(Kh + (size_t)kkey * 64 + kch * 8); gk1 = *(const GAS1 u32x4*)(Kh + (size_t)(64 + kkey) * 64 + kch * 8);
    if (DK == 96) gr = *(const GAS1 u32x4*)(KRs + (size_t)rkey * 32 + rch * 8);
    gv0 = *(const GAS1 u32x4*)(VTh + (size_t)kkey * 64 + kch * 8); gv1 = *(const GAS1 u32x4*)(VTh + (size_t)(64 + kkey) * 64 + kch * 8);
    __syncthreads();
    {
        char* kb = lds; char* vb = lds + KT_B;
        *(u32x4*)(kb + kkey * KROW + kch * 16) = gk0; *(u32x4*)(kb + (64 + kkey) * KROW + kch * 16) = gk1;
        if (DK == 96) *(u32x4*)(kb + rkey * KROW + 128 + rch * 16) = gr;
        *(u32x4*)(vb + kkey * 144 + kch * 16) = gv0; *(u32x4*)(vb + (64 + kkey) * 144 + kch * 16) = gv1;
    }
    __syncthreads();
    for (int t = 0; t < NT; ++t) {
        const char* kb = lds + (t & 1) * BUF_B; const char* vb = kb + KT_B;
        if (t + 1 < NT) {
            const int k0 = (t + 1) * 128;
            gk0 = *(const GAS1 u32x4*)(Kh + (size_t)(k0 + kkey) * 64 + kch * 8); gk1 = *(const GAS1 u32x4*)(Kh + (size_t)(k0 + 64 + kkey) * 64 + kch * 8);
            if (DK == 96) gr = *(const GAS1 u32x4*)(KRs + (size_t)(k0 + rkey) * 32 + rch * 8);
            gv0 = *(const GAS1 u32x4*)(VTh + (size_t)(k0 + kkey) * 64 + kch * 8); gv1 = *(const GAS1 u32x4*)(VTh + (size_t)(k0 + 64 + kkey) * 64 + kch * 8);
        }
        f32x16 p[4];
#pragma unroll
        for (int b = 0; b < 4; ++b)
#pragma unroll
            for (int r = 0; r < 16; ++r) p[b][r] = 0.f;
#pragma unroll
        for (int s = 0; s < NS; ++s)
#pragma unroll
            for (int b = 0; b < 4; ++b) {
                const bf16x8 kf = *(const bf16x8*)(kb + (32 * b + q) * KROW + s * 32 + hi * 16);
                p[b] = __builtin_amdgcn_mfma_f32_32x32x16_bf16(kf, qf[s], p[b], 0, 0, 0);
            }
        float mx4[4];
#pragma unroll
        for (int b = 0; b < 4; ++b) { float m = __builtin_fmaxf(__builtin_fmaxf(p[b][0], p[b][1]), p[b][2]);
#pragma unroll
            for (int r = 3; r < 15; r += 2) m = __builtin_fmaxf(__builtin_fmaxf(m, p[b][r]), p[b][r + 1]);
            mx4[b] = __builtin_fmaxf(m, p[b][15]); }
        float mx = __builtin_fmaxf(__builtin_fmaxf(mx4[0], mx4[1]), __builtin_fmaxf(mx4[2], mx4[3]));
        mx = __builtin_fmaxf(mx, __shfl_xor(mx, 32));
        const float mnew = __builtin_fmaxf(mrun, mx);
        float ps4[4];
#pragma unroll
        for (int b = 0; b < 4; ++b) { float a = 0.f;
#pragma unroll
            for (int r = 0; r < 16; ++r) { p[b][r] = __builtin_amdgcn_exp2f(p[b][r] - mnew); a += p[b][r]; }
            ps4[b] = a; }
        if (__any(mnew != mrun)) {
            const float alpha = __builtin_amdgcn_exp2f(mrun - mnew);
            lsum *= alpha;
#pragma unroll
            for (int r = 0; r < 16; ++r) { o0[r] *= alpha; o1[r] *= alpha; }
        }
        mrun = mnew;
        lsum += (ps4[0] + ps4[1]) + (ps4[2] + ps4[3]);
#pragma unroll
        for (int b = 0; b < 4; ++b)
#pragma unroll
            for (int s = 0; s < 2; ++s) {
                u32x4 pw;
                pw.x = cvtpk_s(p[b][8 * s], p[b][8 * s + 1]); pw.y = cvtpk_s(p[b][8 * s + 2], p[b][8 * s + 3]); pw.z = cvtpk_s(p[b][8 * s + 4], p[b][8 * s + 5]); pw.w = cvtpk_s(p[b][8 * s + 6], p[b][8 * s + 7]);
                const bf16x8 pf = __builtin_bit_cast(bf16x8, pw);
                const int krow0 = 32 * b + 16 * s + 4 * hi + ((lane & 15) >> 2);
                const int cofs = (16 * ((lane >> 4) & 1) + 4 * (lane & 3)) * 2;
                typedef short v4i16_t __attribute__((ext_vector_type(4)));
                typedef __attribute__((address_space(3))) v4i16_t* ldsv4;
                const s16x4 a0 = __builtin_amdgcn_ds_read_tr16_b64_v4i16((ldsv4)(vb + krow0 * 144 + cofs));
                const s16x4 a1 = __builtin_amdgcn_ds_read_tr16_b64_v4i16((ldsv4)(vb + (krow0 + 8) * 144 + cofs));
                const s16x4 b0 = __builtin_amdgcn_ds_read_tr16_b64_v4i16((ldsv4)(vb + krow0 * 144 + 64 + cofs));
                const s16x4 b1 = __builtin_amdgcn_ds_read_tr16_b64_v4i16((ldsv4)(vb + (krow0 + 8) * 144 + 64 + cofs));
                const bf16x8 v0f = __builtin_shufflevector(a0, a1, 0, 1, 2, 3, 4, 5, 6, 7);
                const bf16x8 v1f = __builtin_shufflevector(b0, b1, 0, 1, 2, 3, 4, 5, 6, 7);
                o0 = __builtin_amdgcn_mfma_f32_32x32x16_bf16(v0f, pf, o0, 0, 0, 0);
                o1 = __builtin_amdgcn_mfma_f32_32x32x16_bf16(v1f, pf, o1, 0, 0, 0);
            }
        if (t + 1 < NT) {
            char* kn = lds + ((t + 1) & 1) * BUF_B; char* vn = kn + KT_B;
            *(u32x4*)(kn + kkey * KROW + kch * 16) = gk0; *(u32x4*)(kn + (64 + kkey) * KROW + kch * 16) = gk1;
            if (DK == 96) *(u32x4*)(kn + rkey * KROW + 128 + rch * 16) = gr;
            *(u32x4*)(vn + kkey * 144 + kch * 16) = gv0; *(u32x4*)(vn + (64 + kkey) * 144 + kch * 16) = gv1;
        }
        __syncthreads();
    }
    const float ltot = lsum + __shfl_xor(lsum, 32);
    const float inv = 1.0f / ltot;
    {
        char* stg = lds + wave * 4608;
#pragma unroll
        for (int g4 = 0; g4 < 4; ++g4) {
            const int dv = 8 * g4 + 4 * hi;
            u32x2 w0, w1;
            w0.x = pk2(o0[4 * g4] * inv, o0[4 * g4 + 1] * inv); w0.y = pk2(o0[4 * g4 + 2] * inv, o0[4 * g4 + 3] * inv);
            w1.x = pk2(o1[4 * g4] * inv, o1[4 * g4 + 1] * inv); w1.y = pk2(o1[4 * g4 + 2] * inv, o1[4 * g4 + 3] * inv);
            *(u32x2*)(stg + q * 144 + dv * 2) = w0; *(u32x2*)(stg + q * 144 + 64 + dv * 2) = w1;
        }
        asm volatile("s_waitcnt lgkmcnt(0)" ::: "memory");
#pragma unroll
        for (int i = 0; i < 4; ++i) {
            const int row = i * 8 + (lane >> 3), ch = lane & 7;
            const u32x4 v = *(const u32x4*)(stg + row * 144 + ch * 16);
            *(u32x4*)(Op + (size_t)(wave * 32 + row) * DM + ch * 8) = v;
        }
    }
}

DI void attn_mla_phase(char* lds) {
    FRESH_IDS
    unsigned char* ws = WSP(); asm volatile("" : "+s"(ws));
    const bf16_t* QB = (const bf16_t*)(ws + WS_QB0); const bf16_t* KB = (const bf16_t*)(ws + WS_KB0); const bf16_t* VT = (const bf16_t*)(ws + WS_VT0); const bf16_t* KR = (const bf16_t*)(ws + WS_KR);
    bf16_t* MIX = (bf16_t*)(ws + WS_MIX0);
    const int G = gridDim.x; const int bx = blockIdx.x;
    const int vb = (G % 8 == 0) ? (bx % 8) * (G / 8) + bx / 8 : bx;
    for (int u = vb; u < 512; u += G) {
        int tok0, h, Sk, pos0; unsigned kofs, rofs; const f32x2* rp;
        if (u < 256) { const int qb = u & 7, b = u >> 6; h = (u >> 3) & 7; tok0 = NPR + b * 2048 + qb * 256; Sk = 2560; pos0 = qb * 256; rp = (const f32x2*)(ws + WS_ROPE_A);
            kofs = (32u * 8u * 256u + (unsigned)(b * 8 + h) * 2560u) * 64u; rofs = (unsigned)NPR * 32u + (unsigned)b * 2560u * 32u; }
        else { const int v = u - 256; h = v & 7; const int sq = v >> 3; tok0 = sq * 256; Sk = 256; pos0 = 0; rp = nullptr;
            kofs = (unsigned)(sq * 8 + h) * 256u * 64u; rofs = (unsigned)sq * 256u * 32u; }
        attn_unit<96>(lds, QB + (size_t)tok0 * 768 + h * 96, 768, KB + kofs, KR + rofs, VT + kofs, Sk, MIX + (size_t)tok0 * DM + h * 64, tid, lane, wave, rp, pos0);
    }
    __syncthreads();
}
DI void attn_gqa_phase(char* lds) {
    FRESH_IDS
    unsigned char* ws = WSP(); asm volatile("" : "+s"(ws));
    const bf16_t* QB = (const bf16_t*)(ws + WS_QB1); const bf16_t* KB = (const bf16_t*)(ws + WS_KB1); const bf16_t* VT = (const bf16_t*)(ws + WS_VT1);
    bf16_t* MIX = (bf16_t*)(ws + WS_MIX1);
    const int G = gridDim.x; const int bx = blockIdx.x;
    const int vb = (G % 8 == 0) ? (bx % 8) * (G / 8) + bx / 8 : bx;
    for (int u = vb; u < 1024; u += G) {
        int tok0, h, Sk; unsigned kofs;
        if (u < 512) { const int qb = u & 7, b = u >> 7; h = (u >> 3) & 15; const int kvh = h >> 2; tok0 = NPR + b * 2048 + qb * 256; Sk = 2560;
            kofs = (32u * 4u * 256u + (unsigned)(b * 4 + kvh) * 2560u) * 64u; }
        else { const int v = u - 512; h = v & 15; const int sq = v >> 4, kvh = h >> 2; tok0 = sq * 256; Sk = 256;
            kofs = (unsigned)(sq * 4 + kvh) * 256u * 64u; }
        attn_unit<64>(lds, QB + (size_t)tok0 * DM + h * 64, DM, KB + kofs, nullptr, VT + kofs, Sk, MIX + (size_t)tok0 * DM + h * 64, tid, lane, wave, nullptr, 0);
    }
    __syncthreads();
}


#define LAS __attribute__((address_space(3)))
#define XB_TMO      128
#define XB_XCNT(j)  (256  + 64 * (j))
#define XB_XSUB(j)  (1280 + 64 * (j))
#define XB_XGEN(j)  (2304 + 64 * (j))
#define XB_TOP      3328
#define XB_TOPGEN   3392
#define XCD_BAR_WORDS 3456
#define XB_SPIN_CAP (1u << 18)
__device__ __forceinline__ unsigned xb_ld(unsigned* p)              { return __hip_atomic_load(p, __ATOMIC_RELAXED, __HIP_MEMORY_SCOPE_AGENT); }
__device__ __forceinline__ unsigned xb_add(unsigned* p, unsigned v) { return __hip_atomic_fetch_add(p, v, __ATOMIC_RELAXED, __HIP_MEMORY_SCOPE_AGENT); }
__device__ __forceinline__ unsigned xb_xcc_id() { return (unsigned)__builtin_amdgcn_s_getreg((3 << 11) | 20) & 0xFu; }
#define XB_SPIN(cond, bar) do { unsigned _sp = 0; while (cond) { __builtin_amdgcn_s_sleep(1); \
    if ((++_sp & 255u) == 0u) { if (xb_ld(&(bar)[XB_TMO])) break; if (_sp > XB_SPIN_CAP) { atomicAdd(&(bar)[XB_TMO], 1u); break; } } } } while (0)
struct XcdBarrier { unsigned* bar; unsigned x; volatile LAS unsigned* st; };
__device__ __forceinline__ XcdBarrier xcd_barrier_post(unsigned* bar, volatile LAS unsigned* st) {
    XcdBarrier b; b.bar = bar; b.x = xb_xcc_id(); b.st = st;
    if (threadIdx.x == 0) (void)xb_add(&bar[XB_XCNT(b.x)], 1u);
    return b;
}
__device__ __forceinline__ void xcd_barrier_complete(unsigned* bar, unsigned x, unsigned& nloc, unsigned& nx) {
    const unsigned G = gridDim.x * gridDim.y * gridDim.z;
    unsigned sum, cnt, mine, sp = 0u;
    for (;;) {
        sum = 0u; cnt = 0u; mine = 0u;
#pragma unroll
        for (unsigned j = 0; j < 16; ++j) { const unsigned c = xb_ld(&bar[XB_XCNT(j)]); sum += c; cnt += (c > 0u) ? 1u : 0u; mine = (j == x) ? c : mine; }
        if (sum == G) break;
        __builtin_amdgcn_s_sleep(1);
        if ((++sp & 255u) == 0u) { if (xb_ld(&bar[XB_TMO])) break; if (sp > XB_SPIN_CAP) { atomicAdd(&bar[XB_TMO], 1u); break; } }
    }
    nloc = mine > 0u ? mine : 1u; nx = cnt > 0u ? cnt : 1u;
}
__device__ __forceinline__ void xcd_barrier(unsigned* bar, volatile LAS unsigned* st) {
    asm volatile("s_waitcnt vmcnt(0)" ::: "memory");
    __syncthreads();
    if (threadIdx.x == 0) {
        const unsigned x = xb_xcc_id();
        __builtin_amdgcn_s_waitcnt(0);
        unsigned nloc = st[0], nx = st[1];
        if (nloc == 0u) { xcd_barrier_complete(bar, x, nloc, nx); st[0] = nloc; st[1] = nx; }
        const unsigned old = xb_add(&bar[XB_XSUB(x)], 1u);
        const unsigned gen = old / nloc;
        if (old + 1u == (gen + 1u) * nloc) {
            __builtin_amdgcn_fence(__ATOMIC_RELEASE, "agent");
            asm volatile("s_waitcnt vmcnt(0)" ::: "memory");
            const unsigned og = xb_add(&bar[XB_TOP], 1u);
            const unsigned tg = og / nx;
            if (og + 1u == (tg + 1u) * nx) xb_add(&bar[XB_TOPGEN], 1u);
            else XB_SPIN(xb_ld(&bar[XB_TOPGEN]) == tg, bar);
            __builtin_amdgcn_fence(__ATOMIC_ACQUIRE, "agent");
            xb_add(&bar[XB_XGEN(x)], 1u);
            asm volatile("s_waitcnt vmcnt(0)" ::: "memory");
        } else {
            XB_SPIN(xb_ld(&bar[XB_XGEN(x)]) == gen, bar);
            __builtin_amdgcn_fence(__ATOMIC_ACQUIRE, "agent");
            asm volatile("s_waitcnt vmcnt(0)" ::: "memory");
        }
    }
    __syncthreads();
}

#define WSF() ({ unsigned char* w_ = WSP(); asm volatile("" : "+s"(w_)); w_; })
#define LND_S(p) asm volatile("" : "+s"(p))
__global__ void __launch_bounds__(512, 2) fwd_kernel(Args a) {
    extern __shared__ __attribute__((aligned(16))) unsigned char lds_raw[];
    cg::grid_group grid = cg::this_grid();
    PG8_LAS unsigned char* ldsg = (PG8_LAS unsigned char*)lds_raw;
    char* lds = (char*)lds_raw;
    volatile LAS unsigned* bst = (volatile LAS unsigned*)(ldsg + 131072);
    if (threadIdx.x < 2) bst[threadIdx.x] = 0u;
    if (threadIdx.x < 68) ((LAS unsigned*)(ldsg + LDS_PTAB))[threadIdx.x] = ((const unsigned*)&a)[threadIdx.x];
    __syncthreads();
    (void)xcd_barrier_post((unsigned*)WSP(), bst);
#define GSYNC() do { unsigned* bw_ = (unsigned*)WSP(); asm volatile("" : "+s"(bw_)); xcd_barrier(bw_, bst); } while (0)

    phase0(lds);
    if (WSP() == nullptr) grid.sync();
    GSYNC();
    p0b_phase();
    GSYNC();

    for (int fb = 0; fb < 4; ++fb) {
        const int l = fb >> 1, wh = fb & 1;
        const int kff = 3 * l + 2 * wh;
        {
            unsigned char* ws = WSF(); int G = gridDim.x; LND_S(G);
            pg8::Gemm g{(const bf16_t*)(ws + WS_HB), (const bf16_t*)(ws + WS_WFFIN + fb * WFFIN_SZ), NTOK, 2 * FF, DM}; pg8::StaticOrder S; S.init(NTOK, 2 * FF, G, (int)blockIdx.x);
            EpiSwiglu E{(bf16_t*)(ws + WS_HID), (const float*)(ws + WS_SS) + (size_t)kff * NTOK * 4, (const float*)(ws + WS_BIAS) + (size_t)kff * 5 * 5632};
            pg8::gemm_phase<EpiSwiglu, pg8::StaticOrder, true, true>(ldsg, g, S, E);
            if (fb < 3) {
                const int nun = NTOK / 256 * (2 * FF / 256), nmax = (nun + G - 1) / G, nidle = G * nmax - nun; const int c = (int)blockIdx.x;
                FRESH_IDS
                if (nidle == 0) transpose_set(fb + 1, lds, c * 8 + wave, G * 8, lane, wave);
                else if (c >= G - nidle) transpose_set(fb + 1, lds, (c - (G - nidle)) * 8 + wave, nidle * 8, lane, wave);
            }
        }
        GSYNC();
        {
            unsigned char* ws = WSF(); int G = gridDim.x; LND_S(G); bf16_t* X = (bf16_t*)OUTP(); LND_S(X);
            const float* modl = (const float*)(ws + WS_MOD) + (size_t)l * 5 * NMOD;
            const float* xlo = INP(0);
            const float* xhi = INP(1) - (size_t)NPR * DM;
            if (fb == 1) { FRESH_IDS bias_rows(3, lane, (int)blockIdx.x * 8 + wave, G * 8); bias_rows(4, lane, (int)blockIdx.x * 8 + wave, G * 8); }
            pg8::Gemm g{(const bf16_t*)(ws + WS_HID), (const bf16_t*)(ws + WS_WFFOUT + fb * WFFOUT_SZ), NTOK, DM, FF}; pg8::StaticOrder S; S.init(NTOK, DM, G, (int)blockIdx.x);
            const int kn = kff + 1;
            EpiResid E{xlo, xhi, X, modl + (wh ? 8 : 2) * 1024, (bf16_t*)(ws + WS_HB), (const float*)(ws + WS_GM) + (size_t)kn * 5120, (float*)(ws + WS_SS) + (size_t)kn * NTOK * 4, 0.5f, 1, (kn == 6) ? 1 : 0, (fb != 0) ? 1 : 0};
            pg8::gemm_phase<EpiResid, pg8::StaticOrder, true, true>(ldsg, g, S, E);
        }
        GSYNC();
        if (wh == 0) {
            const int kmx = 3 * l + 1;
            {
                unsigned char* ws = WSF(); int G = gridDim.x; LND_S(G);
                const int N = l ? INC : INA_P;
                pg8::Gemm g{(const bf16_t*)(ws + WS_HB), (const bf16_t*)(ws + (l ? WS_WINC : WS_WINA)), NTOK, N, DM}; pg8::StaticOrder S; S.init(NTOK, N, G, (int)blockIdx.x);
                EpiStore<true> E{(bf16_t*)(ws + WS_RAW), N, 1.0f, (const float*)(ws + WS_SS) + (size_t)kmx * NTOK * 4, (const float*)(ws + WS_BIAS) + (size_t)kmx * 5 * 5632};
                pg8::gemm_phase<EpiStore<true>, pg8::StaticOrder, true, true>(ldsg, g, S, E);
                {
                    const int nun = NTOK / 256 * (N / 256), nmax = (nun + G - 1) / G, nidle = G * nmax - nun; const int c = (int)blockIdx.x;
                    FRESH_IDS
                    if (nidle == 0) bias_rows(3 * l + 2, lane, c * 8 + wave, G * 8);
                    else if (c >= G - nidle) bias_rows(3 * l + 2, lane, (c - (G - nidle)) * 8 + wave, nidle * 8);
                }
            }
            GSYNC();
            if (l == 0) {
                e1_phase(lds);
                GSYNC();
                {
                    unsigned char* ws = WSF(); int G = gridDim.x; LND_S(G);
                    pg8::Gemm g{(const bf16_t*)(ws + WS_CQN), (const bf16_t*)(ws + WS_WQUP), NTOK, 768, 384}; pg8::StaticOrder S; S.init(NTOK, 768, G, (int)blockIdx.x);
                    EpiStore<false> E{(bf16_t*)(ws + WS_QB0), 768, 0.10206207261596575f * LOG2E, nullptr, nullptr};
                    pg8::gemm_phase<EpiStore<false>, pg8::StaticOrder, true, true>(ldsg, g, S, E);
                }
                {
                    unsigned char* ws = WSF(); int G = gridDim.x; LND_S(G);
                    pg8::Gemm g{(const bf16_t*)(ws + WS_CKVN), (const bf16_t*)(ws + WS_WKVUP), 18432, 1024, 256}; pg8::StaticOrder S; S.init(18432, 1024, G, G - 1 - (int)blockIdx.x);
                    EpiKVup E{(bf16_t*)(ws + WS_KB0), (bf16_t*)(ws + WS_VT0)};
                    pg8::gemm_phase<EpiKVup, pg8::StaticOrder, true, true>(ldsg, g, S, E);
                }
                GSYNC();
                attn_mla_phase(lds);
            } else {
                e2_phase();
                GSYNC();
                attn_gqa_phase(lds);
            }
            GSYNC();
            {
                unsigned char* ws = WSF(); int G = gridDim.x; LND_S(G); bf16_t* X = (bf16_t*)OUTP(); LND_S(X);
                const float* modl = (const float*)(ws + WS_MOD) + (size_t)l * 5 * NMOD;
                pg8::Gemm g{(const bf16_t*)(ws + (l ? WS_MIX1 : WS_MIX0)), (const bf16_t*)(ws + (l ? WS_WOUTC : WS_WOUTA)), NTOK, DM, DM}; pg8::StaticOrder S; S.init(NTOK, DM, G, (int)blockIdx.x);
                const int kn = 3 * l + 2;
                EpiResid E{nullptr, nullptr, X, modl + 5 * 1024, (bf16_t*)(ws + WS_HB), (const float*)(ws + WS_GM) + (size_t)kn * 5120, (float*)(ws + WS_SS) + (size_t)kn * NTOK * 4, 1.0f, 1, 0, 1};
                pg8::gemm_phase<EpiResid, pg8::StaticOrder, true, true>(ldsg, g, S, E);
            }
            GSYNC();
        }
    }
    final_phase();
}

constexpr int LDS_BYTES = 136192;

extern "C" void kernel_launch(void* const* d_in, const int* in_sizes, int n_in, void* d_out, int out_size, void* d_ws, size_t ws_size, hipStream_t stream) {
    static int grid = 0;
    if (grid == 0) {
        if (n_in != 32 || ws_size < WS_END) { fprintf(stderr, "kernel_launch: unexpected n_in %d / ws %zu (need %zu)\n", n_in, ws_size, (size_t)WS_END); grid = -1; return; }
        int dev = 0, cus = 0, per_cu = 0;
        (void)hipGetDevice(&dev);
        (void)hipDeviceGetAttribute(&cus, hipDeviceAttributeMultiprocessorCount, dev);
        (void)hipFuncSetAttribute((const void*)fwd_kernel, hipFuncAttributeMaxDynamicSharedMemorySize, LDS_BYTES);
        if (hipOccupancyMaxActiveBlocksPerMultiprocessor(&per_cu, (const void*)fwd_kernel, 512, LDS_BYTES) != hipSuccess || per_cu < 1) per_cu = 1;
        (void)hipGetLastError();
        grid = cus * per_cu;
        if (grid > 256) grid = 256;
        if (grid < 1) grid = 256;
    }
    if (grid < 0) return;
    (void)hipMemsetAsync(d_ws, 0, WS_MOD + (size_t)2 * 5 * NMOD * 4, stream);
    Args a{};
    for (int i = 0; i < 32; ++i) a.in[i] = (const float*)d_in[i];
    a.out = (float*)d_out; a.ws = (unsigned char*)d_ws;
    void* args[] = {&a};
    hipError_t e = hipLaunchCooperativeKernel((const void*)fwd_kernel, dim3(grid), dim3(512), args, LDS_BYTES, stream);
    if (e != hipSuccess) fprintf(stderr, "cooperative launch failed: %s (grid %d)\n", hipGetErrorString(e), grid);
}
```
